# Optimizing an MI355X kernel written in HIP

```python
import jax, jax.numpy as jnp
from jax import lax
import numpy as np

D_MODEL = 2048
BATCH = 1
SEQ = 8192
DEPTH = 1
DEC_BATCH = 16
DEC_SEQ = 16
PAST_LEN = 4096

CHUNK = 64
QBLOCK = 128
HEAD_DIM = 128
N_HEADS_SB = 8
N_HEADS_FOX = 8
W_SB = N_HEADS_SB * HEAD_DIM
W_FOX = N_HEADS_FOX * HEAD_DIM
RMS_EPS = 1e-6
FORGET_BIAS_INIT = 3.0
SPLITS = [W_SB, W_SB, W_SB, W_SB, W_FOX, W_FOX, W_FOX, W_FOX, N_HEADS_FOX, D_MODEL, D_MODEL]
D_IN = 4 * W_SB + 4 * W_FOX + N_HEADS_FOX + 2 * D_MODEL

kernel_name = "stickbreak_fox_gated_hybrid_step"


def _split_points():
    pts, acc = [], 0
    for w in SPLITS[:-1]:
        acc += w
        pts.append(acc)
    return pts


def rms_norm(x, w):
    xf = x.astype(jnp.float32)
    y = xf * lax.rsqrt(jnp.mean(xf * xf, axis=-1, keepdims=True) + RMS_EPS)
    return (y * w.astype(jnp.float32)).astype(x.dtype)


def _sweep(block_fn, q_pos, *q_arrays):
    tq = q_pos.shape[0]
    qb = tq if tq <= QBLOCK else QBLOCK
    nb = tq // qb

    def to_blocks(a):
        a = a.reshape(a.shape[0], nb, qb, *a.shape[2:])
        return jnp.moveaxis(a, 1, 0)

    blocks = (q_pos.reshape(nb, qb),) + tuple(to_blocks(a) for a in q_arrays)
    out = lax.map(lambda args: block_fn(*args), blocks)
    out = jnp.moveaxis(out, 0, 1)
    return out.reshape(out.shape[0], tq, *out.shape[3:])


def stick_breaking_block(qpos, q, k, v, kpos):
    z = jnp.einsum("bqhd,bkhd->bhqk", q.astype(jnp.float32), k.astype(jnp.float32)) * (HEAD_DIM ** -0.5)
    mask = (kpos[None, :] < qpos[:, None])[None, None]
    log_one_minus = jnp.where(mask, jax.nn.log_sigmoid(-z), 0.0)
    later = lax.cumsum(log_one_minus, axis=3, reverse=True) - log_one_minus
    w = jnp.where(mask, jnp.exp(jax.nn.log_sigmoid(z) + later), 0.0)
    return jnp.einsum("bhqk,bkhd->bqhd", w, v.astype(jnp.float32)).astype(v.dtype)


def forgetting_block(qpos, q, f_q, k, v, f_k, kpos):
    z = jnp.einsum("bqhd,bkhd->bhqk", q.astype(jnp.float32), k.astype(jnp.float32)) * (HEAD_DIM ** -0.5)
    decay = jnp.transpose(f_q, (0, 2, 1))[..., :, None] - jnp.transpose(f_k, (0, 2, 1))[..., None, :]
    mask = (kpos[None, :] <= qpos[:, None])[None, None]
    p = jax.nn.softmax(jnp.where(mask, z + decay, -jnp.inf), axis=-1)
    return jnp.einsum("bhqk,bkhd->bqhd", p, v.astype(jnp.float32)).astype(v.dtype)


def hybrid_layer(x, past_sb_k, past_sb_v, past_fox_k, past_fox_v, past_fox_logf,
                 norm_w, w_in, b_forget, q_norm_w, k_norm_w, w_branch_sb, w_branch_fox, w_out):
    bsz, t_new, _ = x.shape
    p_len = 0 if past_sb_k is None else past_sb_k.shape[1]
    h = rms_norm(x, norm_w)
    proj = jnp.einsum("btd,de->bte", h, w_in)
    (q_sb, k_sb, v_sb, g_sb, q_fx, k_fx, v_fx, g_fx,
     f_logit, m_sb, m_fx) = jnp.split(proj, _split_points(), axis=-1)

    heads_sb = lambda a: a.reshape(bsz, t_new, N_HEADS_SB, HEAD_DIM)
    heads_fx = lambda a: a.reshape(bsz, t_new, N_HEADS_FOX, HEAD_DIM)
    q_sb, k_sb, v_sb = heads_sb(q_sb), heads_sb(k_sb), heads_sb(v_sb)
    q_fx = rms_norm(heads_fx(q_fx), q_norm_w)
    k_fx = rms_norm(heads_fx(k_fx), k_norm_w)
    v_fx = heads_fx(v_fx)
    log_f = jax.nn.log_sigmoid(f_logit.astype(jnp.float32) + b_forget.astype(jnp.float32))

    q_pos = p_len + jnp.arange(t_new)
    k_pos = jnp.arange(p_len + t_new)
    if past_sb_k is None:
        ks_all, vs_all, kf_all, vf_all, lf_all = k_sb, v_sb, k_fx, v_fx, log_f
    else:
        ks_all = jnp.concatenate([past_sb_k.astype(k_sb.dtype), k_sb], axis=1)
        vs_all = jnp.concatenate([past_sb_v.astype(v_sb.dtype), v_sb], axis=1)
        kf_all = jnp.concatenate([past_fox_k.astype(k_fx.dtype), k_fx], axis=1)
        vf_all = jnp.concatenate([past_fox_v.astype(v_fx.dtype), v_fx], axis=1)
        lf_all = jnp.concatenate([past_fox_logf.astype(jnp.float32), log_f], axis=1)
    f_cum = lax.cumsum(lf_all, axis=1)
    f_q = f_cum[:, p_len:]

    o_sb = _sweep(lambda qp, qq: stick_breaking_block(qp, qq, ks_all, vs_all, k_pos), q_pos, q_sb)
    o_fx = _sweep(lambda qp, qq, fq: forgetting_block(qp, qq, fq, kf_all, vf_all, f_cum, k_pos),
                  q_pos, q_fx, f_q)

    u_sb = jnp.einsum("btc,cd->btd", o_sb.reshape(bsz, t_new, W_SB) * jax.nn.silu(g_sb), w_branch_sb)
    u_fx = jnp.einsum("btc,cd->btd", o_fx.reshape(bsz, t_new, W_FOX) * jax.nn.silu(g_fx), w_branch_fox)
    merged = jax.nn.sigmoid(m_sb) * u_sb + jax.nn.sigmoid(m_fx) * u_fx
    y = x + jnp.einsum("btd,de->bte", merged, w_out)
    return y, k_sb, v_sb, k_fx, v_fx, log_f


def setup_inputs(seed: int = 0) -> dict:
    key = jax.random.key(seed)
    ks = jax.random.split(key, 16)
    f32 = jnp.float32
    n = lambda k, shape, scale: jax.random.normal(k, shape, f32) * scale
    return {
        "x_prompt": n(ks[0], (BATCH, SEQ, D_MODEL), 1.0),
        "x_sample": n(ks[1], (DEC_BATCH, DEC_SEQ, D_MODEL), 1.0),
        "cache_sb_k": n(ks[2], (DEPTH, DEC_BATCH, PAST_LEN, N_HEADS_SB, HEAD_DIM), 1.0),
        "cache_sb_v": n(ks[3], (DEPTH, DEC_BATCH, PAST_LEN, N_HEADS_SB, HEAD_DIM), 1.0),
        "cache_fox_k": n(ks[4], (DEPTH, DEC_BATCH, PAST_LEN, N_HEADS_FOX, HEAD_DIM), 1.0),
        "cache_fox_v": n(ks[5], (DEPTH, DEC_BATCH, PAST_LEN, N_HEADS_FOX, HEAD_DIM), 1.0),
        "cache_fox_logf": jax.nn.log_sigmoid(FORGET_BIAS_INIT + n(ks[6], (DEPTH, DEC_BATCH, PAST_LEN, N_HEADS_FOX), 1.0)),
        "norm_w": 1.0 + n(ks[7], (DEPTH, D_MODEL), 0.02),
        "w_in": n(ks[8], (DEPTH, D_MODEL, D_IN), D_MODEL ** -0.5),
        "b_forget": FORGET_BIAS_INIT + n(ks[9], (DEPTH, N_HEADS_FOX), 0.1),
        "q_norm_w": 1.0 + n(ks[10], (DEPTH, HEAD_DIM), 0.02),
        "k_norm_w": 1.0 + n(ks[11], (DEPTH, HEAD_DIM), 0.02),
        "w_branch_sb": n(ks[12], (DEPTH, W_SB, D_MODEL), W_SB ** -0.5),
        "w_branch_fox": n(ks[13], (DEPTH, W_FOX, D_MODEL), W_FOX ** -0.5),
        "w_out": n(ks[14], (DEPTH, D_MODEL, D_MODEL), D_MODEL ** -0.5),
    }


def reference(x_prompt, x_sample, cache_sb_k, cache_sb_v, cache_fox_k, cache_fox_v, cache_fox_logf,
              norm_w, w_in, b_forget, q_norm_w, k_norm_w, w_branch_sb, w_branch_fox, w_out):
    y_prompt, y_sample = x_prompt, x_sample
    p_sbk, p_sbv, p_fxk, p_fxv, p_lf = [], [], [], [], []
    s_sbk, s_sbv, s_fxk, s_fxv, s_lf = [], [], [], [], []
    for l in range(DEPTH):
        wl = (norm_w[l], w_in[l], b_forget[l], q_norm_w[l], k_norm_w[l],
              w_branch_sb[l], w_branch_fox[l], w_out[l])
        y_prompt, a, b, c, d, e = hybrid_layer(y_prompt, None, None, None, None, None, *wl)
        p_sbk.append(a); p_sbv.append(b); p_fxk.append(c); p_fxv.append(d); p_lf.append(e)
        y_sample, a, b, c, d, e = hybrid_layer(y_sample, cache_sb_k[l], cache_sb_v[l], cache_fox_k[l],
                                               cache_fox_v[l], cache_fox_logf[l], *wl)
        s_sbk.append(a); s_sbv.append(b); s_fxk.append(c); s_fxv.append(d); s_lf.append(e)
    return (y_prompt, y_sample,
            jnp.stack(p_sbk), jnp.stack(p_sbv), jnp.stack(p_fxk), jnp.stack(p_fxv), jnp.stack(p_lf),
            jnp.stack(s_sbk), jnp.stack(s_sbv), jnp.stack(s_fxk), jnp.stack(s_fxv), jnp.stack(s_lf))
```

```cpp
#include <hip/hip_runtime.h>
#include <cstdio>
#include <cstdint>

#ifndef MK_N_LAUNCHES
#define MK_N_LAUNCHES 1
#endif
#ifndef PROBE_DOUBLE
#define PROBE_DOUBLE -1
#endif
constexpr int N_PHASES = 5;
constexpr int N_LAUNCHES = MK_N_LAUNCHES;

#define GAS __attribute__((address_space(1)))
#define LAS __attribute__((address_space(3)))
typedef unsigned short bf16;
typedef short bf16x8 __attribute__((ext_vector_type(8)));
typedef short s16x4 __attribute__((ext_vector_type(4)));
typedef float f32x4 __attribute__((ext_vector_type(4)));
typedef float f32x16 __attribute__((ext_vector_type(16)));
typedef unsigned u32x4 __attribute__((ext_vector_type(4)));
typedef unsigned u32x2 __attribute__((ext_vector_type(2)));

constexpr int DM = 2048, TP = 8192, NBAT = 16, NSEQ = 16, PAST = 4096, NH = 8, HD = 128, WB = 1024;
constexpr int TS = NBAT * NSEQ;
constexpr int TT = TP + TS;
constexpr int DIN = 12296, NPROJ = 12288;
constexpr int KT = PAST + NSEQ;
constexpr float RMS_EPS = 1e-6f;
constexpr float LOG2E = 1.4426950408889634f;
constexpr float QSCALE = 0.08838834764831845f * 1.4426950408889634f;

constexpr size_t O_YP = 0, O_YS = 16777216, O_PSBK = 17301504, O_PSBV = 25690112, O_PFXK = 34078720, O_PFXV = 42467328, O_PLF = 50855936,
                 O_SSBK = 50921472, O_SSBV = 51183616, O_SFXK = 51445760, O_SFXV = 51707904, O_SLF = 51970048, O_END = 51972096;

constexpr size_t MiB = 1u << 20;
constexpr size_t WS_CTL = 0, CTL_ZERO_BYTES = 1 * MiB;
constexpr int CW_QUEUE = 32768;
constexpr size_t WS_WIN = 2 * MiB;
constexpr size_t WS_WB = 50 * MiB;
constexpr size_t WS_WO = 58 * MiB;
constexpr size_t WS_H = 66 * MiB;
constexpr size_t WS_ACT = 99 * MiB, ACT_STRIDE = 17 * MiB;
constexpr size_t WS_MSIG = 235 * MiB;
constexpr size_t WS_ACAT = 301 * MiB;
constexpr size_t WS_MRG = 334 * MiB;
constexpr size_t WS_F2P = 367 * MiB;
constexpr size_t WS_F2S = 368 * MiB;
constexpr size_t WS_KMX = 372 * MiB;
constexpr size_t WS_END = 373 * MiB;
constexpr int KN_TILES = 96;
constexpr int WGM_P1 = 3, WGM_P3 = 4, WGM_P4 = 4;
constexpr float NEG_BITS = 64.0f, NEG_EPS = 5.0e-20f;
enum { A_QSB = 0, A_KSB, A_VSB, A_GSB, A_QFX, A_KFX, A_VFX, A_GFX };

constexpr int LDS_BYTES = 163840;
constexpr int XCH_OFF = 131072;
constexpr int MISC_OFF = 163328;

#define LDS_WAIT() asm volatile("s_waitcnt lgkmcnt(0)" ::: "memory")
#define VM_WAIT() asm volatile("s_waitcnt vmcnt(0)" ::: "memory")
__device__ __forceinline__ unsigned cvt_pk_bf16(float lo, float hi) { unsigned r; asm volatile("v_cvt_pk_bf16_f32 %0, %1, %2" : "=v"(r) : "v"(lo), "v"(hi)); return r; }
__device__ __forceinline__ float bf_lo(unsigned w) { return __builtin_bit_cast(float, w << 16); }
__device__ __forceinline__ float bf_hi(unsigned w) { return __builtin_bit_cast(float, w & 0xffff0000u); }
__device__ __forceinline__ float bf2f(bf16 v) { return __builtin_bit_cast(float, (unsigned)v << 16); }
__device__ __forceinline__ float fast_sigmoid(float v) { return __builtin_amdgcn_rcpf(1.0f + __builtin_amdgcn_exp2f(-v * LOG2E)); }

__device__ __forceinline__ int lane_id() { int r; asm volatile("v_mbcnt_lo_u32_b32 %0, -1, 0\n\tv_mbcnt_hi_u32_b32 %0, -1, %0" : "=v"(r)); return r; }
namespace pg8 {
constexpr int BM = 256, BK = 64, HALF = 128, HTB = HALF * BK * 2, STAGE_BYTES = 8 * HTB, NXCD = 8;
__host__ __device__ __forceinline__ int lds_byte(int r, int c) { const int st = (r >> 4) * 2 + (c >> 5), rr = r & 15, cc = c & 31, ob = rr * 64 + cc * 2; return st * 1024 + (ob ^ (((ob >> 9) & 1) << 5)); }
__host__ __device__ __forceinline__ void stage_rc(int b, int& R, int& C) { const int st = b / 1024, sb = b % 1024, swz = sb ^ (((sb >> 9) & 1) << 5); R = (st >> 1) * 16 + swz / 64; C = (st & 1) * 32 + (swz % 64) / 2; }
__host__ __device__ __forceinline__ int perm32(int rho) { const int n = rho >> 4, i = rho & 15; return 8 * (i >> 2) + 4 * n + (i & 3); }

struct Unit { int pm, pn; };
struct Gemm { const bf16* A; const bf16* Bt; int M, N, K; };

struct StaticOrder {
    int nM, nN, nwg, G, c, WGM;
    __host__ __device__ void init(int M, int N, int G_, int c_, int wgm_) { nM = M / BM; nN = N / BM; nwg = nM * nN; G = G_; c = c_; WGM = wgm_; }
    __host__ __device__ bool next(int i, Unit& u) const {
        const long L = (long)i * G + c; if (L >= nwg) return false;
        int wgid = (int)L; { const int q = nwg / NXCD, r = nwg % NXCD, xcd = wgid % NXCD, off = wgid / NXCD; wgid = (xcd < r ? xcd * (q + 1) : r * (q + 1) + (xcd - r) * q) + off; }
        const int nig = WGM * nN, gid = wgid / nig, fm = gid * WGM, gsz = (nM - fm) < WGM ? (nM - fm) : WGM;
        u.pm = fm + ((wgid % nig) % gsz); u.pn = (wgid % nig) / gsz; return true;
    }
    __device__ __forceinline__ void a_ready(const Unit&) const {}
    __device__ __forceinline__ void done(const Unit&) const {}
};


struct EpiInProj {
    static constexpr bool PERM = true, AFTER_DRAIN = false, MIDK = false;
    unsigned char* ws; float* out; const float* qnw; const float* knw; LAS float* xch;
    __device__ __forceinline__ void operator()(f32x4 (&acc)[2][2][4][2], const Unit& u, int wr, int wc, int fr, int fq) const {
        const int grp = u.pn >> 2;
        const int rowl0 = wr * 64 + fr, colq = wc * 32 + 8 * fq;
        const bool sample = (u.pm >= TP / 256);
        if (grp == 4 || grp == 5) {
            const float* nw = (grp == 4) ? qnw : knw;
            const f32x4 w0 = *(const f32x4*)(nw + colq), w1 = *(const f32x4*)(nw + colq + 4);
#pragma unroll
            for (int ai = 0; ai < 2; ++ai)
#pragma unroll
                for (int m = 0; m < 4; ++m)
#pragma unroll
                    for (int bj = 0; bj < 2; ++bj) {
                        const f32x4 a = acc[ai][bj][m][0], b = acc[ai][bj][m][1];
                        float s = (a[0] * a[0] + a[1] * a[1]) + (a[2] * a[2] + a[3] * a[3]) + (b[0] * b[0] + b[1] * b[1]) + (b[2] * b[2] + b[3] * b[3]);
                        s += __shfl_xor(s, 16); s += __shfl_xor(s, 32);
                        if (fq == 0) xch[(ai * 128 + rowl0 + 16 * m) * 8 + bj * 4 + wc] = s;
                    }
            LDS_WAIT(); __builtin_amdgcn_s_barrier(); asm volatile("" ::: "memory");
            const float post = (grp == 4) ? QSCALE : 1.0f;
#pragma unroll
            for (int ai = 0; ai < 2; ++ai)
#pragma unroll
                for (int m = 0; m < 4; ++m)
#pragma unroll
                    for (int bj = 0; bj < 2; ++bj) {
                        const f32x4 t = *(const LAS f32x4*)(xch + (ai * 128 + rowl0 + 16 * m) * 8 + bj * 4);
                        const float tot = (t[0] + t[1]) + (t[2] + t[3]);
                        const float rs = __builtin_amdgcn_rsqf(tot * (1.0f / 128.0f) + RMS_EPS) * post;
                        acc[ai][bj][m][0] = acc[ai][bj][m][0] * rs * w0; acc[ai][bj][m][1] = acc[ai][bj][m][1] * rs * w1;
                    }
        }
        bf16* bdst; int bld; int bcol0; float* fdst = nullptr; int mode = 0;
        if (grp < 8) { bdst = (bf16*)(ws + WS_ACT + (size_t)grp * ACT_STRIDE); bld = 1024; bcol0 = (u.pn & 3) * 256;
            if (grp == 0) mode = 1; else if (grp == 3 || grp == 7) mode = 2;
            if (grp == 1) fdst = out + (sample ? O_SSBK : O_PSBK); else if (grp == 2) fdst = out + (sample ? O_SSBV : O_PSBV);
            else if (grp == 5) fdst = out + (sample ? O_SFXK : O_PFXK); else if (grp == 6) fdst = out + (sample ? O_SFXV : O_PFXV);
        } else { bdst = (bf16*)(ws + WS_MSIG); bld = 4096; bcol0 = (u.pn - 32) * 256; mode = 3; }
        const int frow_off = sample ? TP : 0;
#pragma unroll
        for (int ai = 0; ai < 2; ++ai)
#pragma unroll
            for (int m = 0; m < 4; ++m) {
                const int row = u.pm * 256 + ai * 128 + rowl0 + 16 * m;
#pragma unroll
                for (int bj = 0; bj < 2; ++bj) {
                    f32x4 v0 = acc[ai][bj][m][0], v1 = acc[ai][bj][m][1];
                    const int col = bcol0 + bj * 128 + colq;
                    if (fdst) { float* fp = fdst + (size_t)(row - frow_off) * 1024 + col; *(f32x4*)fp = v0; *(f32x4*)(fp + 4) = v1; }
                    if (mode == 1) { v0 = v0 * QSCALE; v1 = v1 * QSCALE; }
                    else if (mode == 2) {
#pragma unroll
                        for (int j = 0; j < 4; ++j) { v0[j] = v0[j] * fast_sigmoid(v0[j]); v1[j] = v1[j] * fast_sigmoid(v1[j]); } }
                    else if (mode == 3) {
#pragma unroll
                        for (int j = 0; j < 4; ++j) { v0[j] = fast_sigmoid(v0[j]); v1[j] = fast_sigmoid(v1[j]); } }
                    u32x4 w; w.x = cvt_pk_bf16(v0[0], v0[1]); w.y = cvt_pk_bf16(v0[2], v0[3]); w.z = cvt_pk_bf16(v1[0], v1[1]); w.w = cvt_pk_bf16(v1[2], v1[3]);
                    if (grp < 8) *(u32x4*)(bdst + ((size_t)(((u.pn & 3) * 2 + bj) * TT + row)) * 128 + colq) = w;
                    else if (sample) *(u32x4*)(bdst + (size_t)row * bld + col) = w;
                    else *(u32x4*)(bdst + (size_t)(u.pm * 16 + (u.pn - 32)) * 65536 + (size_t)((ai * 4 + m) * 2 + bj) * 4096 + (size_t)(((wr * 4 + wc) * 64 + fq * 16 + fr) * 8)) = w;
                }
            }
    }
};

struct EpiMerge {
    static constexpr bool PERM = true, AFTER_DRAIN = false, MIDK = true;
    const bf16* msig; bf16* mrg;
    template <bool FINAL>
    __device__ __forceinline__ void apply(f32x4 (&acc)[2][2][4][2], const Unit& u, int wr, int wc, int fr, int fq) const {
        const int rowl0 = wr * 64 + fr, colq = wc * 32 + 8 * fq;
        int pm_ = u.pm; asm volatile("" : "+s"(pm_));
#pragma unroll
        for (int ai = 0; ai < 2; ++ai)
#pragma unroll
            for (int m = 0; m < 4; ++m) {
                const int row = pm_ * 256 + ai * 128 + rowl0 + 16 * m;
#pragma unroll
                for (int bj = 0; bj < 2; ++bj) {
                    const int col = u.pn * 256 + bj * 128 + colq;
                    const bf16* gt = msig + (size_t)(pm_ * 16 + u.pn) * 65536 + (size_t)((ai * 4 + m) * 2 + bj) * 4096 + (size_t)(((wr * 4 + wc) * 64 + fq * 16 + fr) * 8);
                    const u32x4 gf = *(const u32x4*)(gt + (size_t)8 * 65536);
                    float f[8] = {bf_lo(gf.x), bf_hi(gf.x), bf_lo(gf.y), bf_hi(gf.y), bf_lo(gf.z), bf_hi(gf.z), bf_lo(gf.w), bf_hi(gf.w)};
#pragma unroll
                    for (int j = 0; j < 8; ++j) f[j] = fmaxf(f[j], 1e-30f);
                    if (!FINAL) {
                        const u32x4 gs = *(const u32x4*)gt;
                        const float s[8] = {bf_lo(gs.x), bf_hi(gs.x), bf_lo(gs.y), bf_hi(gs.y), bf_lo(gs.z), bf_hi(gs.z), bf_lo(gs.w), bf_hi(gs.w)};
#pragma unroll
                        for (int j = 0; j < 4; ++j) { acc[ai][bj][m][0][j] *= s[j] * __builtin_amdgcn_rcpf(f[j]); acc[ai][bj][m][1][j] *= s[4 + j] * __builtin_amdgcn_rcpf(f[4 + j]); }
                    } else {
                        const f32x4 v0 = acc[ai][bj][m][0], v1 = acc[ai][bj][m][1];
                        u32x4 w; w.x = cvt_pk_bf16(v0[0] * f[0], v0[1] * f[1]); w.y = cvt_pk_bf16(v0[2] * f[2], v0[3] * f[3]);
                        w.z = cvt_pk_bf16(v1[0] * f[4], v1[1] * f[5]); w.w = cvt_pk_bf16(v1[2] * f[6], v1[3] * f[7]);
                        *(u32x4*)(mrg + (size_t)row * 2048 + col) = w;
                    }
                    asm volatile("" ::: "memory");
                }
            }
    }
    __device__ __forceinline__ void mid(f32x4 (&acc)[2][2][4][2], const Unit& u, int wr, int wc, int fr, int fq) const { apply<false>(acc, u, wr, wc, fr, fq); }
    __device__ __forceinline__ void operator()(f32x4 (&acc)[2][2][4][2], const Unit& u, int wr, int wc, int fr, int fq) const { apply<true>(acc, u, wr, wc, fr, fq); }
};

struct EpiOut {
    static constexpr bool PERM = false, AFTER_DRAIN = false, MIDK = false;
    const float* xp; const float* xs; float* y;
    __device__ __forceinline__ void operator()(f32x4 (&acc)[2][2][4][2], const Unit& u, int wr, int wc, int fr, int fq) const {
        const int rowl0 = wr * 64 + fr, colq = wc * 32 + 4 * fq;
#pragma unroll
        for (int ai = 0; ai < 2; ++ai)
#pragma unroll
            for (int m = 0; m < 4; ++m) {
                const int row = u.pm * 256 + ai * 128 + rowl0 + 16 * m;
                const float* xr = (row < TP) ? xp + (size_t)row * DM : xs + (size_t)(row - TP) * DM;
                float* yr = y + (size_t)row * DM;
#pragma unroll
                for (int bj = 0; bj < 2; ++bj)
#pragma unroll
                    for (int n = 0; n < 2; ++n) { const int c = u.pn * 256 + bj * 128 + colq + 16 * n; *(f32x4*)(yr + c) = acc[ai][bj][m][n] + *(const f32x4*)(xr + c); }
                asm volatile("" ::: "memory");
            }
    }
};

template <class Epi, class Sched, bool ALIGN_EPI = false, bool SP2 = false>
__device__ __forceinline__ void gemm_phase(LAS unsigned char* lds, const Gemm g, const Sched& S, const Epi& E, int wave_) {
    const int wid = wave_, lane = lane_id(), tid = wid * 64 + lane, wr = wid >> 2, wc = wid & 3, fr = lane & 15, fq = lane >> 4;
    const int K = g.K, nt = K / BK;
    unsigned voffA[2], voffB[2];
#pragma unroll
    for (int i = 0; i < 2; ++i) { int R, C; stage_rc(tid * 16 + i * 8192, R, C); const int Rb = Epi::PERM ? ((R & ~31) + perm32(R & 31)) : R;
        voffA[i] = (unsigned)(R * K + C) * 2u; voffB[i] = (unsigned)(Rb * K + C) * 2u; }
    const size_t kstep = (size_t)(BK * 2);
    const size_t hstep = (size_t)HALF * K * 2;
    const size_t tstep = 2 * hstep;
    const unsigned ldsw = (unsigned)wid * 1024u;
    const int aoff = lds_byte(wr * 64 + fr, fq * 8), boff = lds_byte(wc * 32 + fr, fq * 8);
#define PG8_SA(b, h) (((b) * 2 + (h)) * HTB)
#define PG8_SB(b, h) ((4 + (b) * 2 + (h)) * HTB)
#define PG8_STAGE(bufoff, gbase, voff) do { _Pragma("unroll") for (int _i = 0; _i < 2; ++_i) \
        __builtin_amdgcn_global_load_lds((const unsigned*)((const char*)(gbase) + (voff)[_i]), (LAS unsigned*)(lds + (bufoff) + ldsw + _i * 8192), 16, 0, 0); } while (0)
#define PG8_LDA(dst, b, h) do { _Pragma("unroll") for (int m = 0; m < 4; ++m) _Pragma("unroll") for (int k = 0; k < 2; ++k) dst[m][k] = *(const LAS bf16x8*)(lds + PG8_SA(b, h) + aoff + m * 2048 + k * 1024); } while (0)
#define PG8_LDB(dst, b, h) do { _Pragma("unroll") for (int n = 0; n < 2; ++n) _Pragma("unroll") for (int k = 0; k < 2; ++k) dst[n][k] = *(const LAS bf16x8*)(lds + PG8_SB(b, h) + boff + n * 2048 + k * 1024); } while (0)
#define PG8_MMA(ai, bj, At, Bt) do { __builtin_amdgcn_s_setprio(1); _Pragma("unroll") for (int m = 0; m < 4; ++m) _Pragma("unroll") for (int n = 0; n < 2; ++n) _Pragma("unroll") for (int k = 0; k < 2; ++k) \
        acc[ai][bj][m][n] = __builtin_amdgcn_mfma_f32_16x16x32_bf16(Bt[n][k], At[m][k], acc[ai][bj][m][n], 0, 0, 0); __builtin_amdgcn_s_setprio(0); } while (0)
#define PG8_WAIT_V(n) asm volatile("s_waitcnt vmcnt(" #n ")" ::: "memory")
#define PG8_WAIT_L(n) asm volatile("s_waitcnt lgkmcnt(" #n ")" ::: "memory")
#define PG8_BAR __builtin_amdgcn_s_barrier()
#define PG8_SCHED __builtin_amdgcn_sched_barrier(0)
    Unit cur, nxt; int ui = 0;
    if (!S.next(0, cur)) return;
    f32x4 acc[2][2][4][2];
#pragma unroll
    for (int a = 0; a < 2; ++a)
#pragma unroll
        for (int b = 0; b < 2; ++b)
#pragma unroll
            for (int m = 0; m < 4; ++m)
#pragma unroll
                for (int n = 0; n < 2; ++n) acc[a][b][m][n] = (f32x4){0.f, 0.f, 0.f, 0.f};
    bf16x8 At[4][2], B0[2][2], B1[2][2];
    const char* cA = (const char*)g.A + (size_t)cur.pm * tstep; const char* cB = (const char*)g.Bt + (size_t)cur.pn * tstep;
    S.a_ready(cur);
    if constexpr (SP2) {
        PG8_STAGE(PG8_SB(0, 0), cB, voffB); PG8_STAGE(PG8_SB(0, 1), cB + hstep, voffB); PG8_STAGE(PG8_SA(0, 0), cA, voffA); PG8_STAGE(PG8_SA(0, 1), cA + hstep, voffA);
        if (wr == 1) PG8_BAR;
        PG8_WAIT_V(2); PG8_BAR;
        PG8_STAGE(PG8_SB(1, 0), cB + kstep, voffB); PG8_STAGE(PG8_SA(1, 0), cA + kstep, voffA); PG8_STAGE(PG8_SB(1, 1), cB + hstep + kstep, voffB);
        PG8_WAIT_V(6); PG8_BAR;
    } else {
        PG8_STAGE(PG8_SB(0, 0), cB, voffB); PG8_STAGE(PG8_SA(0, 0), cA, voffA); PG8_STAGE(PG8_SB(0, 1), cB + hstep, voffB); PG8_STAGE(PG8_SA(0, 1), cA + hstep, voffA);
        if (wr == 1) PG8_BAR;
        PG8_WAIT_V(4); PG8_BAR;
        PG8_STAGE(PG8_SB(1, 0), cB + kstep, voffB); PG8_STAGE(PG8_SA(1, 0), cA + kstep, voffA); PG8_STAGE(PG8_SB(1, 1), cB + hstep + kstep, voffB);
        PG8_WAIT_V(6); PG8_BAR;
    }
    for (;;) {
        const bool has_next = S.next(ui + 1, nxt);
        const char* nA = has_next ? (const char*)g.A + (size_t)nxt.pm * tstep : cA; const char* nB = has_next ? (const char*)g.Bt + (size_t)nxt.pn * tstep : cB;
        for (int t = 0; t < nt; t += 2) {
            const bool last = (t == nt - 2);
            const char* a1 = cA + (size_t)(t + 1) * kstep;
            const char* a2 = last ? nA : cA + (size_t)(t + 2) * kstep; const char* b2 = last ? nB : cB + (size_t)(t + 2) * kstep;
            const char* a3 = a2 + kstep; const char* b3 = b2 + kstep;
            if (last && has_next) S.a_ready(nxt);
            if constexpr (Epi::MIDK) { if (t == nt / 2) E.mid(acc, cur, wr, wc, fr, fq); }
            if constexpr (SP2) {
            PG8_LDB(B0, 0, 0); PG8_LDB(B1, 0, 1); PG8_SCHED; PG8_LDA(At, 0, 0); PG8_STAGE(PG8_SA(1, 1), a1 + hstep, voffA);
            PG8_WAIT_V(8); PG8_WAIT_L(0); PG8_BAR; PG8_MMA(0, 0, At, B0); PG8_MMA(0, 1, At, B1); PG8_BAR; PG8_SCHED;
            PG8_LDA(At, 0, 1); PG8_STAGE(PG8_SB(0, 0), b2, voffB); PG8_STAGE(PG8_SB(0, 1), b2 + hstep, voffB); PG8_STAGE(PG8_SA(0, 0), a2, voffA);
            PG8_WAIT_V(8); PG8_WAIT_L(0); PG8_BAR; PG8_MMA(1, 0, At, B0); PG8_MMA(1, 1, At, B1); PG8_BAR; PG8_SCHED;
            PG8_LDB(B0, 1, 0); PG8_LDB(B1, 1, 1); PG8_SCHED; PG8_LDA(At, 1, 0); PG8_STAGE(PG8_SA(0, 1), a2 + hstep, voffA);
            PG8_WAIT_V(8); PG8_WAIT_L(0); PG8_BAR; PG8_MMA(0, 0, At, B0); PG8_MMA(0, 1, At, B1); PG8_BAR; PG8_SCHED;
            PG8_LDA(At, 1, 1); PG8_STAGE(PG8_SB(1, 0), b3, voffB); PG8_STAGE(PG8_SB(1, 1), b3 + hstep, voffB); PG8_STAGE(PG8_SA(1, 0), a3, voffA);
            PG8_WAIT_V(8); PG8_WAIT_L(0); PG8_BAR; PG8_MMA(1, 0, At, B0); PG8_MMA(1, 1, At, B1); PG8_BAR; PG8_SCHED;
            } else {
            PG8_LDB(B0, 0, 0); PG8_SCHED; PG8_LDA(At, 0, 0); PG8_STAGE(PG8_SA(1, 1), a1 + hstep, voffA);
            PG8_WAIT_L(8); PG8_BAR; PG8_WAIT_L(0); PG8_MMA(0, 0, At, B0); PG8_BAR; PG8_SCHED;
            PG8_LDB(B1, 0, 1); PG8_STAGE(PG8_SB(0, 0), b2, voffB);
            PG8_BAR; PG8_WAIT_L(0); PG8_MMA(0, 1, At, B1); PG8_BAR;
            PG8_LDA(At, 0, 1); PG8_STAGE(PG8_SA(0, 0), a2, voffA);
            PG8_BAR; PG8_WAIT_L(0); PG8_MMA(1, 0, At, B0); PG8_BAR; PG8_SCHED;
            PG8_STAGE(PG8_SB(0, 1), b2 + hstep, voffB);
            PG8_WAIT_V(6); PG8_BAR; PG8_MMA(1, 1, At, B1); PG8_BAR;
            PG8_LDB(B0, 1, 0); PG8_SCHED; PG8_LDA(At, 1, 0); PG8_STAGE(PG8_SA(0, 1), a2 + hstep, voffA);
            PG8_WAIT_L(8); PG8_BAR; PG8_WAIT_L(0); PG8_MMA(0, 0, At, B0); PG8_BAR; PG8_SCHED;
            PG8_LDB(B1, 1, 1); PG8_STAGE(PG8_SB(1, 0), b3, voffB);
            PG8_BAR; PG8_WAIT_L(0); PG8_MMA(0, 1, At, B1); PG8_BAR;
            PG8_LDA(At, 1, 1); PG8_STAGE(PG8_SA(1, 0), a3, voffA);
            PG8_BAR; PG8_WAIT_L(0); PG8_MMA(1, 0, At, B0); PG8_BAR; PG8_SCHED;
            PG8_STAGE(PG8_SB(1, 1), b3 + hstep, voffB);
            PG8_WAIT_V(6); PG8_BAR; PG8_MMA(1, 1, At, B1); PG8_BAR;
            }
        }
        if constexpr (ALIGN_EPI) { if (wr == 0) PG8_BAR; }
        E(acc, cur, wr, wc, fr, fq); S.done(cur);
        if (!has_next) break;
#pragma unroll
        for (int a = 0; a < 2; ++a)
#pragma unroll
            for (int b = 0; b < 2; ++b)
#pragma unroll
                for (int m = 0; m < 4; ++m)
#pragma unroll
                    for (int n = 0; n < 2; ++n) acc[a][b][m][n] = (f32x4){0.f, 0.f, 0.f, 0.f};
        cur = nxt; cA = nA; cB = nB; ++ui;
        if constexpr (ALIGN_EPI) { if (wr == 1) PG8_BAR; }
    }
    PG8_WAIT_V(0);
    if constexpr (!ALIGN_EPI) { if (wr == 0) PG8_BAR; }
    PG8_BAR;
#undef PG8_SA
#undef PG8_SB
#undef PG8_STAGE
#undef PG8_LDA
#undef PG8_LDB
#undef PG8_MMA
#undef PG8_WAIT_V
#undef PG8_WAIT_L
#undef PG8_BAR
#undef PG8_SCHED
}
}

template <int MODE>
__device__ __forceinline__ void mini_gemm(LAS unsigned char* lds, const bf16* A, const bf16* Bt, int unit, int wave, int lane, int tid, const bf16* msig_s, bf16* mrg_s, const float* xs, float* ys) {
    const int r0 = (unit >> 6) * 64, c0 = (unit & 63) * 32;
    const int m = lane & 15, kq = lane >> 4;
    const bf16* ap = A + (size_t)(r0 + m) * 2048 + wave * 256 + 8 * kq;
    const bf16* bp = Bt + (size_t)(c0 + m) * 2048 + wave * 256 + 8 * kq;
    f32x4 acc[4][2];
#pragma unroll
    for (int i = 0; i < 4; ++i) { acc[i][0] = (f32x4){0.f, 0.f, 0.f, 0.f}; acc[i][1] = acc[i][0]; }
    bf16x8 fa[4][4], fb[4][2];
    const bf16* ap1 = ap + 16 * 2048; const bf16* ap2 = ap + 32 * 2048; const bf16* ap3 = ap + 48 * 2048; const bf16* bp1 = bp + 16 * 2048;
#define MG_LD(dst_, ptr_, st_) asm volatile("global_load_dwordx4 %0, %1, off offset:%2" : "=&v"(dst_) : "v"(ptr_), "n"(64 * (st_)) : "memory")
#define MG_LOAD(st_) do { MG_LD(fa[(st_) & 3][0], ap, st_); MG_LD(fa[(st_) & 3][1], ap1, st_); MG_LD(fa[(st_) & 3][2], ap2, st_); MG_LD(fa[(st_) & 3][3], ap3, st_); \
                          MG_LD(fb[(st_) & 3][0], bp, st_); MG_LD(fb[(st_) & 3][1], bp1, st_); } while (0)
    const int rl = tid >> 3, cl = (tid & 7) * 4, row = r0 + rl, col = c0 + cl;
    u32x2 gs, gf; f32x4 xin;
    if (MODE == 0) { gs = *(const u32x2*)(msig_s + (size_t)row * 4096 + col); gf = *(const u32x2*)(msig_s + (size_t)row * 4096 + 2048 + col); }
    else xin = *(const f32x4*)(xs + (size_t)row * 2048 + col);
    __builtin_amdgcn_sched_barrier(0);
    MG_LOAD(0); MG_LOAD(1); MG_LOAD(2); MG_LOAD(3);
#pragma unroll
    for (int st = 0; st < 8; ++st) {
        __builtin_amdgcn_sched_barrier(0);
        if (st <= 4) asm volatile("s_waitcnt vmcnt(18)" ::: "memory"); else if (st == 5) asm volatile("s_waitcnt vmcnt(12)" ::: "memory");
        else if (st == 6) asm volatile("s_waitcnt vmcnt(6)" ::: "memory"); else asm volatile("s_waitcnt vmcnt(0)" ::: "memory");
        __builtin_amdgcn_sched_barrier(0);
#pragma unroll
        for (int i = 0; i < 4; ++i)
#pragma unroll
            for (int j = 0; j < 2; ++j) acc[i][j] = __builtin_amdgcn_mfma_f32_16x16x32_bf16(fb[st & 3][j], fa[st & 3][i], acc[i][j], 0, 0, 0);
        __builtin_amdgcn_sched_barrier(0);
        if (st + 4 < 8) MG_LOAD(st + 4);
    }
#undef MG_LOAD
#undef MG_LD
    LAS float* part = (LAS float*)lds + wave * 2048;
#pragma unroll
    for (int i = 0; i < 4; ++i)
#pragma unroll
        for (int j = 0; j < 2; ++j) *(LAS f32x4*)(part + (16 * i + m) * 32 + 16 * j + 4 * kq) = acc[i][j];
    LDS_WAIT(); __syncthreads();
    {
        const LAS float* pp = (const LAS float*)lds + rl * 32 + cl;
        f32x4 s1 = *(const LAS f32x4*)pp + *(const LAS f32x4*)(pp + 2048) + *(const LAS f32x4*)(pp + 4096) + *(const LAS f32x4*)(pp + 6144);
        f32x4 s2 = *(const LAS f32x4*)(pp + 8192) + *(const LAS f32x4*)(pp + 10240) + *(const LAS f32x4*)(pp + 12288) + *(const LAS f32x4*)(pp + 14336);
        if (MODE == 0) {
            u32x2 w; w.x = cvt_pk_bf16(s1[0] * bf_lo(gs.x) + s2[0] * bf_lo(gf.x), s1[1] * bf_hi(gs.x) + s2[1] * bf_hi(gf.x));
            w.y = cvt_pk_bf16(s1[2] * bf_lo(gs.y) + s2[2] * bf_lo(gf.y), s1[3] * bf_hi(gs.y) + s2[3] * bf_hi(gf.y));
            *(u32x2*)(mrg_s + (size_t)row * 2048 + col) = w;
        } else {
            *(f32x4*)(ys + (size_t)row * 2048 + col) = s1 + s2 + xin;
        }
    }
    LDS_WAIT(); __syncthreads();
}

#define XB_TMO      128
#define XB_XCNT(j)  (256  + 64 * (j))
#define XB_XSUB(j)  (1280 + 64 * (j))
#define XB_XGEN(j)  (2304 + 64 * (j))
#define XB_TOP      3328
#define XB_TOPGEN   3392
#define XCD_BAR_WORDS 3456
#define XB_SPIN_CAP (1u << 18)
__device__ __forceinline__ unsigned xb_ld(unsigned* p)              { return __hip_atomic_load(p, __ATOMIC_RELAXED, __HIP_MEMORY_SCOPE_AGENT); }
__device__ __forceinline__ unsigned xb_add(unsigned* p, unsigned v) { return __hip_atomic_fetch_add(p, v, __ATOMIC_RELAXED, __HIP_MEMORY_SCOPE_AGENT); }
__device__ __forceinline__ unsigned xb_xcc_id() { return (unsigned)__builtin_amdgcn_s_getreg((3 << 11) | 20) & 0xFu; }
#define XB_SPIN(cond, bar) do { unsigned _sp = 0; while (cond) { __builtin_amdgcn_s_sleep(1); \
    if ((++_sp & 255u) == 0u) { if (xb_ld(&(bar)[XB_TMO])) break; if (_sp > XB_SPIN_CAP) { atomicAdd(&(bar)[XB_TMO], 1u); break; } } } } while (0)
struct XcdBarrier { unsigned* bar; unsigned x; volatile LAS unsigned* st; int wave; };
__device__ __forceinline__ XcdBarrier xcd_barrier_post(unsigned* bar, volatile LAS unsigned* st, int wave) {
    XcdBarrier b; b.bar = bar; b.x = xb_xcc_id(); b.st = st; b.wave = wave;
    if (wave == 0 && lane_id() == 0) (void)xb_add(&bar[XB_XCNT(b.x)], 1u);
    return b;
}
__device__ __forceinline__ void xcd_barrier_complete(unsigned* bar, unsigned x, unsigned& nloc, unsigned& nx) {
    const unsigned G = gridDim.x * gridDim.y * gridDim.z;
    unsigned sum, cnt, mine, sp = 0u;
    for (;;) {
        sum = 0u; cnt = 0u; mine = 0u;
#pragma unroll
        for (unsigned j = 0; j < 16; ++j) { const unsigned c = xb_ld(&bar[XB_XCNT(j)]); sum += c; cnt += (c > 0u) ? 1u : 0u; mine = (j == x) ? c : mine; }
        if (sum == G) break;
        __builtin_amdgcn_s_sleep(1);
        if ((++sp & 255u) == 0u) { if (xb_ld(&bar[XB_TMO])) break; if (sp > XB_SPIN_CAP) { atomicAdd(&bar[XB_TMO], 1u); break; } }
    }
    nloc = mine > 0u ? mine : 1u; nx = cnt > 0u ? cnt : 1u;
}
__device__ __forceinline__ void xcd_barrier(const XcdBarrier& b) {
    asm volatile("s_waitcnt vmcnt(0)" ::: "memory");
    __syncthreads();
    if (b.wave == 0 && lane_id() == 0) {
        unsigned* bar = b.bar;
        __builtin_amdgcn_s_waitcnt(0);
        unsigned nloc = b.st[0], nx = b.st[1];
        if (nloc == 0u) { xcd_barrier_complete(bar, b.x, nloc, nx); b.st[0] = nloc; b.st[1] = nx; }
        const unsigned old = xb_add(&bar[XB_XSUB(b.x)], 1u);
        const unsigned gen = old / nloc;
        if (old + 1u == (gen + 1u) * nloc) {
            __builtin_amdgcn_fence(__ATOMIC_RELEASE, "agent");
            asm volatile("s_waitcnt vmcnt(0)" ::: "memory");
            const unsigned og = xb_add(&bar[XB_TOP], 1u);
            const unsigned tg = og / nx;
            if (og + 1u == (tg + 1u) * nx) xb_add(&bar[XB_TOPGEN], 1u);
            else XB_SPIN(xb_ld(&bar[XB_TOPGEN]) == tg, bar);
            __builtin_amdgcn_fence(__ATOMIC_ACQUIRE, "agent");
            xb_add(&bar[XB_XGEN(b.x)], 1u);
            asm volatile("s_waitcnt vmcnt(0)" ::: "memory");
        } else {
            XB_SPIN(xb_ld(&bar[XB_XGEN(b.x)]) == gen, bar);
            __builtin_amdgcn_fence(__ATOMIC_ACQUIRE, "agent");
            asm volatile("s_waitcnt vmcnt(0)" ::: "memory");
        }
    }
    __syncthreads();
}

__device__ __forceinline__ float wave_sum(float v) {
#pragma unroll
    for (int o = 1; o < 64; o <<= 1) v += __shfl_xor(v, o);
    return v;
}
__device__ __forceinline__ void p0_transpose_item(const float* W, int ld, int nblk, bf16* WT, int ldt, LAS float* scr, int item, int lane) {
    const int kb = item / nblk, nb = item % nblk, k0 = 64 * kb, n0 = 32 * nb;
#pragma unroll 8
    for (int i = 0; i < 32; ++i) { const int kk = 2 * i + (lane >> 5); scr[kk * 33 + (lane & 31)] = W[(size_t)(k0 + kk) * ld + n0 + (lane & 31)]; }
    LDS_WAIT(); asm volatile("" ::: "memory");
    const int c = lane & 7;
#pragma unroll
    for (int j = 0; j < 4; ++j) { const int n = (lane >> 3) + 8 * j; const LAS float* s = scr + (8 * c) * 33 + n;
        u32x4 o; o.x = cvt_pk_bf16(s[0 * 33], s[1 * 33]); o.y = cvt_pk_bf16(s[2 * 33], s[3 * 33]); o.z = cvt_pk_bf16(s[4 * 33], s[5 * 33]); o.w = cvt_pk_bf16(s[6 * 33], s[7 * 33]);
        *(u32x4*)(WT + (size_t)(n0 + n) * ldt + k0 + 8 * c) = o; }
    LDS_WAIT(); asm volatile("" ::: "memory");
}

struct Ptrs {
    const float *xp, *xs, *csbk, *csbv, *cfxk, *cfxv, *cflf, *normw, *win, *bfor, *qnw, *knw, *wbsb, *wbfx, *wout;
    float* out; unsigned char* ws;
};

__device__ __forceinline__ void p0_prologue(const Ptrs& P, LAS unsigned char* lds, int gw, int NGW, int wave, int lane, int tid) {
    LAS float* wfT = (LAS float*)(lds + 69632);
    for (int i = tid; i < 2048 * 2; i += 512) { const int k = i >> 1, hf = i & 1; const f32x4 v = *(const f32x4*)(P.win + (size_t)k * DIN + 8192 + 4 * hf);
#pragma unroll
        for (int j = 0; j < 4; ++j) wfT[(4 * hf + j) * 2048 + k] = v[j]; }
    LAS float* scr = (LAS float*)(lds + wave * 8448);
    constexpr int I_A = 32 * 256, I_B = 32 * 128, NITEMS = I_A + I_B;
    bf16* Wt = (bf16*)(P.ws + WS_WIN);
    for (int it = gw; it < NITEMS; it += NGW) {
        int r = it;
        if (r < I_A) { p0_transpose_item(P.win, DIN, 256, Wt, 2048, scr, r, lane); continue; } r -= I_A;
        p0_transpose_item(P.win + 8200, DIN, 128, Wt + (size_t)8192 * 2048, 2048, scr, r, lane);
    }
    __syncthreads();
    f32x4 nw[8];
#pragma unroll
    for (int i = 0; i < 8; ++i) nw[i] = *(const f32x4*)(P.normw + 4 * lane + 256 * i);
    bf16* H = (bf16*)(P.ws + WS_H);
    for (int m = gw; m < TT; m += NGW) {
        const float* xr = (m < TP) ? P.xp + (size_t)m * DM : P.xs + (size_t)(m - TP) * DM;
        f32x4 v[8]; float ss = 0.f;
#pragma unroll
        for (int i = 0; i < 8; ++i) { v[i] = *(const f32x4*)(xr + 4 * lane + 256 * i); ss += (v[i][0] * v[i][0] + v[i][1] * v[i][1]) + (v[i][2] * v[i][2] + v[i][3] * v[i][3]); }
        const float rstd = 1.0f / sqrtf(wave_sum(ss) * (1.0f / DM) + RMS_EPS);
        unsigned long long* o8 = (unsigned long long*)(H + (size_t)m * DM) + lane;
        float fl[8] = {0.f, 0.f, 0.f, 0.f, 0.f, 0.f, 0.f, 0.f};
#pragma unroll
        for (int i = 0; i < 8; ++i) { v[i] = v[i] * rstd * nw[i];
            o8[64 * i] = (unsigned long long)cvt_pk_bf16(v[i][0], v[i][1]) | ((unsigned long long)cvt_pk_bf16(v[i][2], v[i][3]) << 32);
#pragma unroll
            for (int j = 0; j < 8; ++j) { const f32x4 w = *(const LAS f32x4*)(wfT + j * 2048 + 4 * lane + 256 * i); fl[j] += (v[i][0] * w[0] + v[i][1] * w[1]) + (v[i][2] * w[2] + v[i][3] * w[3]); } }
        float mine = 0.f;
#pragma unroll
        for (int j = 0; j < 8; ++j) { const float t = wave_sum(fl[j]); mine = (lane == j) ? t : mine; }
        if (lane < 8) { const float z = mine + P.bfor[lane]; const float lf = fminf(z, 0.f) - log1pf(expf(-fabsf(z)));
            float* dst = (m < TP) ? P.out + O_PLF + (size_t)m * 8 : P.out + O_SLF + (size_t)(m - TP) * 8; dst[lane] = lf; }
    }
}

__device__ __forceinline__ void p1_side_weights(const Ptrs& P, LAS unsigned char* lds, int sw, int nsw, int wave, int lane) {
    LAS float* scr = (LAS float*)(lds + wave * 8448);
    constexpr int I_S = 16 * 64, I_O = 32 * 64, NITEMS = 2 * I_S + I_O;
    bf16* Wb = (bf16*)(P.ws + WS_WB); bf16* Wo = (bf16*)(P.ws + WS_WO);
    for (int it = sw; it < NITEMS; it += nsw) {
        int r = it;
        if (r < I_S) { p0_transpose_item(P.wbsb, 2048, 64, Wb, 2048, scr, r, lane); continue; } r -= I_S;
        if (r < I_S) { p0_transpose_item(P.wbfx, 2048, 64, Wb + 1024, 2048, scr, r, lane); continue; } r -= I_S;
        p0_transpose_item(P.wout, 2048, 64, Wo, 2048, scr, r, lane);
    }
}

__device__ __forceinline__ void p1_side_knorm(const Ptrs& P, int sw, int nsw, int lane) {
    const int r32 = lane & 31, hi = lane >> 5;
    float* kmx = (float*)(P.ws + WS_KMX);
    for (int it = sw; it < NBAT * NH * KN_TILES; it += nsw) {
        const int h = it & 7, bt = it >> 3, b = bt / KN_TILES, tix = bt - b * KN_TILES, bh = b * 8 + h;
        const float* src = P.cfxk + ((size_t)(b * PAST + tix * 32 + hi) * NH + h) * HD + r32 * 4;
        float mx = 0.f;
#pragma unroll 1
        for (int half = 0; half < 2; ++half) {
            f32x4 t[8];
#pragma unroll
            for (int i = 0; i < 8; ++i) t[i] = __builtin_nontemporal_load((const f32x4*)(src + (size_t)(half * 8 + i) * 2 * NH * HD));
#pragma unroll
            for (int i = 0; i < 8; ++i) { float s_ = t[i][0] * t[i][0] + t[i][1] * t[i][1] + t[i][2] * t[i][2] + t[i][3] * t[i][3];
#pragma unroll
                for (int o = 1; o < 32; o <<= 1) s_ += __shfl_xor(s_, o);
                mx = fmaxf(mx, s_); }
        }
        mx = fmaxf(mx, __shfl_xor(mx, 32));
        if (lane == 0) kmx[bh * 128 + tix] = mx;
    }
}

__device__ __forceinline__ void scan_seq(const Ptrs& P, LAS unsigned char* lds, int id, int tid) {
    LAS float* sm = (LAS float*)(lds + XCH_OFF);
    const float* s1; int n1, st1; const float* s2; int n2; float* dst;
    if (id < 8) { s1 = P.out + O_PLF + id; n1 = TP; st1 = 8; s2 = s1; n2 = 0; dst = (float*)(P.ws + WS_F2P) + (size_t)id * TP; }
    else { const int b = (id - 8) >> 3, j = (id - 8) & 7; s1 = P.cflf + (size_t)b * PAST * 8 + j; n1 = PAST; st1 = 8; s2 = P.out + O_SLF + (size_t)b * NSEQ * 8 + j; n2 = NSEQ;
        dst = (float*)(P.ws + WS_F2S) + (size_t)(b * 8 + j) * KT; }
    const int n = n1 + n2, CH = (n + 511) / 512;
    float v[16]; float run = 0.f;
#pragma unroll
    for (int i = 0; i < 16; ++i) { const int idx = tid * CH + i; if (i < CH && idx < n) { const float x = idx < n1 ? s1[(size_t)idx * st1] : s2[(size_t)(idx - n1) * 8]; run += x; } v[i] = run; }
    const int lane = tid & 63, wave = tid >> 6;
    float inc = run;
#pragma unroll
    for (int o = 1; o < 64; o <<= 1) { const float t = __shfl_up(inc, o); if (lane >= o) inc += t; }
    if (lane == 63) sm[wave] = inc;
    LDS_WAIT(); __syncthreads();
    float base = inc - run;
    for (int w = 0; w < wave; ++w) base += sm[w];
#pragma unroll
    for (int i = 0; i < 16; ++i) { const int idx = tid * CH + i; if (i < CH && idx < n) dst[idx] = (base + v[i]) * LOG2E; }
    __syncthreads();
}

namespace att {
constexpr int SHM_T = 16384;
#define KSWZ(row, colB) ((row) * 256 + ((colB) ^ (((row) & 7) << 4)))
__device__ __forceinline__ int v_st(int k, int c) { const int kk = (k & ~0xC) | ((k & 4) << 1) | ((k & 8) >> 1); return ((kk >> 3) * 4 + (c >> 5)) * 512 + ((kk & 7) * 32 + (c & 31)) * 2; }
__device__ __forceinline__ int v_rd_base(int lane) { return ((lane & 3) << 3) | (((lane >> 2) & 3) << 6) | (((lane >> 4) & 1) << 5) | (((lane >> 5) & 1) << 8); }
__device__ __forceinline__ int crow(int r, int hi) { return (r & 3) + 8 * (r >> 2) + 4 * hi; }

__device__ __forceinline__ __amdgpu_buffer_rsrc_t mk_rsrc(const void* p, int bytes) {
    const unsigned long long a = (unsigned long long)p;
    const unsigned lo = __builtin_amdgcn_readfirstlane((unsigned)a), hi = __builtin_amdgcn_readfirstlane((unsigned)(a >> 32));
    return __builtin_amdgcn_make_buffer_rsrc((void*)(((unsigned long long)hi << 32) | lo), 0, bytes, 0x00020000);
}
template <int NB>
__device__ __forceinline__ void qkt(f32x16& p0, f32x16& p1, const LAS char* Kb, int r32, int hi, const bf16x8 (&qr)[8]) {
    p0 = (f32x16){0.f, 0.f, 0.f, 0.f, 0.f, 0.f, 0.f, 0.f, 0.f, 0.f, 0.f, 0.f, 0.f, 0.f, 0.f, 0.f}; p1 = p0;
    const LAS char* kb[4];
#pragma unroll
    for (int dd = 0; dd < 4; ++dd) kb[dd] = Kb + KSWZ(r32, (dd * 16 + hi * 8) * 2);
#pragma unroll
    for (int d0 = 0; d0 < 8; ++d0) { const LAS char* a = kb[d0 & 3] + (d0 >> 2) * 128;
        const bf16x8 b0 = *(const LAS bf16x8*)a;
        p0 = __builtin_amdgcn_mfma_f32_32x32x16_bf16(b0, qr[d0], p0, 0, 0, 0);
        if (NB == 2) { const bf16x8 b1 = *(const LAS bf16x8*)(a + 32 * 256); p1 = __builtin_amdgcn_mfma_f32_32x32x16_bf16(b1, qr[d0], p1, 0, 0, 0); } }
}
__device__ __forceinline__ void qkt_qlds(f32x16& p0, const LAS char* Kb, const LAS char* Qb, int r32, int hi, int qrow) {
    p0 = (f32x16){0.f, 0.f, 0.f, 0.f, 0.f, 0.f, 0.f, 0.f, 0.f, 0.f, 0.f, 0.f, 0.f, 0.f, 0.f, 0.f};
    const LAS char* kb[4];
#pragma unroll
    for (int dd = 0; dd < 4; ++dd) kb[dd] = Kb + KSWZ(r32, (dd * 16 + hi * 8) * 2);
    const LAS char* qb = Qb + qrow * 256;
#pragma unroll
    for (int d0 = 0; d0 < 8; ++d0) { const LAS char* a = kb[d0 & 3] + (d0 >> 2) * 128;
        const bf16x8 b0 = *(const LAS bf16x8*)a;
        const bf16x8 q = *(const LAS bf16x8*)(qb + (((d0 * 2 + hi) ^ qrow) << 4));
        p0 = __builtin_amdgcn_mfma_f32_32x32x16_bf16(b0, q, p0, 0, 0, 0); }
}
template <int NB>
__device__ __forceinline__ void pv_tile(f32x16 (&o)[4], int vb0, bf16x8 pa0, bf16x8 pa1, bf16x8 pa2, bf16x8 pa3) {
#define TRRD(dst, off) asm volatile("ds_read_b64_tr_b16 %0, %1 offset:%2" : "=&v"(dst) : "v"(vb0), "i"(off) : "memory")
#define PV_D0(d0) do { s16x4 l0, l1, l2, l3, h0, h1, h2, h3; constexpr int b_ = (d0) * 512;   \
        TRRD(l0, b_); TRRD(h0, b_ + 2048); TRRD(l1, b_ + 4096); TRRD(h1, b_ + 6144);   \
        if (NB == 2) { TRRD(l2, b_ + 8192); TRRD(h2, b_ + 10240); TRRD(l3, b_ + 12288); TRRD(h3, b_ + 14336); }   \
        asm volatile("s_waitcnt lgkmcnt(0)" ::: "memory"); __builtin_amdgcn_sched_barrier(0);   \
        o[d0] = __builtin_amdgcn_mfma_f32_32x32x16_bf16(pa0, (bf16x8){l0[0], l0[1], l0[2], l0[3], h0[0], h0[1], h0[2], h0[3]}, o[d0], 0, 0, 0);   \
        o[d0] = __builtin_amdgcn_mfma_f32_32x32x16_bf16(pa1, (bf16x8){l1[0], l1[1], l1[2], l1[3], h1[0], h1[1], h1[2], h1[3]}, o[d0], 0, 0, 0);   \
        if (NB == 2) {   \
        o[d0] = __builtin_amdgcn_mfma_f32_32x32x16_bf16(pa2, (bf16x8){l2[0], l2[1], l2[2], l2[3], h2[0], h2[1], h2[2], h2[3]}, o[d0], 0, 0, 0);   \
        o[d0] = __builtin_amdgcn_mfma_f32_32x32x16_bf16(pa3, (bf16x8){l3[0], l3[1], l3[2], l3[3], h3[0], h3[1], h3[2], h3[3]}, o[d0], 0, 0, 0); } } while (0)
    PV_D0(0); PV_D0(1); PV_D0(2); PV_D0(3);
#undef PV_D0
#undef TRRD
}
#define PK4(P, B_, OUT) do { unsigned a0 = cvt_pk_bf16(P[B_+0], P[B_+1]), a1 = cvt_pk_bf16(P[B_+2], P[B_+3]);   \
        unsigned b0 = cvt_pk_bf16(P[B_+4], P[B_+5]), b1 = cvt_pk_bf16(P[B_+6], P[B_+7]);   \
        auto r0 = __builtin_amdgcn_permlane32_swap(a0, b0, false, false); auto r1 = __builtin_amdgcn_permlane32_swap(a1, b1, false, false);   \
        u32x4 w = {r0[0], r1[0], r0[1], r1[1]}; OUT = __builtin_bit_cast(bf16x8, w); } while (0)

__device__ __forceinline__ void xchg32(float v, float& x0, float& x1) {
    const unsigned a = __builtin_bit_cast(unsigned, v);
    auto rr = __builtin_amdgcn_permlane32_swap(a, a, false, false);
    const unsigned r0 = rr[0], r1 = rr[1];
    x0 = __builtin_bit_cast(float, r0); x1 = __builtin_bit_cast(float, r1);
}
template <int NB, bool MASK>
__device__ __forceinline__ float sb_step_a(f32x16& p0, f32x16& p1, int dq, int hi, float (&PS)[8], float (&GS)[8]) {
#pragma unroll
    for (int r = 0; r < 16; ++r) {
        const int c = (r & 3) + 8 * (r >> 2);
        float a = __builtin_amdgcn_rcpf(1.0f + __builtin_amdgcn_exp2f(p0[r])); if (MASK) a = (c < dq) ? a : 1.0f; p0[r] = a;
        if (NB == 2) { float b = __builtin_amdgcn_rcpf(1.0f + __builtin_amdgcn_exp2f(p1[r])); if (MASK) b = (c + 32 < dq) ? b : 1.0f; p1[r] = b; }
    }
    float tot = 1.0f;
#pragma unroll
    for (int g = 0; g < 4 * NB; ++g) {
        const int r = 4 * (g & 3);
        const float G = (g < 4) ? (p0[r] * p0[r + 1]) * (p0[r + 2] * p0[r + 3]) : (p1[r] * p1[r + 1]) * (p1[r + 2] * p1[r + 3]);
        float x0, x1; xchg32(G, x0, x1);
        PS[g] = x0 * x1; GS[g] = hi ? 1.0f : x1; tot *= PS[g];
    }
    return tot;
}
template <int NB>
__device__ __forceinline__ void sb_step_b(f32x16& p0, f32x16& p1, float C, const float (&PS)[8], const float (&GS)[8], bf16x8& pa0, bf16x8& pa1, bf16x8& pa2, bf16x8& pa3) {
    float X = C;
#pragma unroll
    for (int g = 4 * NB - 1; g >= 0; --g) {
        const int r = 4 * (g & 3);
        const float E = X * GS[g];
        if (g < 4) { const float a0 = p0[r], a1 = p0[r + 1], a2 = p0[r + 2], a3 = p0[r + 3]; const float P3 = E, P2 = P3 * a3, P1 = P2 * a2, P0 = P1 * a1;
            p0[r + 3] = __builtin_fmaf(-P3, a3, P3); p0[r + 2] = __builtin_fmaf(-P2, a2, P2); p0[r + 1] = __builtin_fmaf(-P1, a1, P1); p0[r] = __builtin_fmaf(-P0, a0, P0); }
        else { const float a0 = p1[r], a1 = p1[r + 1], a2 = p1[r + 2], a3 = p1[r + 3]; const float P3 = E, P2 = P3 * a3, P1 = P2 * a2, P0 = P1 * a1;
            p1[r + 3] = __builtin_fmaf(-P3, a3, P3); p1[r + 2] = __builtin_fmaf(-P2, a2, P2); p1[r + 1] = __builtin_fmaf(-P1, a1, P1); p1[r] = __builtin_fmaf(-P0, a0, P0); }
        X *= PS[g];
    }
    PK4(p0, 0, pa0); PK4(p0, 8, pa1);
    if (NB == 2) { PK4(p1, 0, pa2); PK4(p1, 8, pa3); }
}
template <int NB, bool MASK, class FPtr>
__device__ __forceinline__ float fox_weights(f32x16& p0, f32x16& p1, FPtr F2k, int dq, float& m, float& l, float& alpha, bf16x8& pa0, bf16x8& pa1, bf16x8& pa2, bf16x8& pa3) {
    const float NEG = -__builtin_inff();
    float mx = NEG;
#pragma unroll
    for (int g = 0; g < 4; ++g) {
        const f32x4 f0 = F2k[2 * g];
#pragma unroll
        for (int i = 0; i < 4; ++i) { float x = p0[4 * g + i] - f0[i]; if (MASK) x = (i + 8 * g <= dq) ? x : NEG; p0[4 * g + i] = x; mx = fmaxf(mx, x); }
        if (NB == 2) { const f32x4 f1 = F2k[8 + 2 * g];
#pragma unroll
            for (int i = 0; i < 4; ++i) { float x = p1[4 * g + i] - f1[i]; if (MASK) x = (i + 8 * g + 32 <= dq) ? x : NEG; p1[4 * g + i] = x; mx = fmaxf(mx, x); } }
    }
    { float x0, x1; xchg32(mx, x0, x1); mx = fmaxf(x0, x1); }
    const float mn = fmaxf(m, mx);
    alpha = __builtin_amdgcn_exp2f(m - mn); m = mn;
    float ps = 0.f;
#pragma unroll
    for (int r = 0; r < 16; ++r) { p0[r] = __builtin_amdgcn_exp2f(p0[r] - mn); ps += p0[r]; if (NB == 2) { p1[r] = __builtin_amdgcn_exp2f(p1[r] - mn); ps += p1[r]; } }
    { float x0, x1; xchg32(ps, x0, x1); ps = x0 + x1; }
    l = l * alpha + ps;
    PK4(p0, 0, pa0); PK4(p0, 8, pa1);
    if (NB == 2) { PK4(p1, 0, pa2); PK4(p1, 8, pa3); }
    return ps;
}

__device__ __forceinline__ void qk_half(f32x16& p, const LAS char* Kb, int r32, int hi, const LAS char* qx, int rx) {
    p = (f32x16){0.f, 0.f, 0.f, 0.f, 0.f, 0.f, 0.f, 0.f, 0.f, 0.f, 0.f, 0.f, 0.f, 0.f, 0.f, 0.f};
    const LAS char* kb[4];
#pragma unroll
    for (int dd = 0; dd < 4; ++dd) kb[dd] = Kb + KSWZ(r32, (dd * 16 + hi * 8) * 2);
#pragma unroll
    for (int d0 = 0; d0 < 8; ++d0) { const bf16x8 b0 = *(const LAS bf16x8*)(kb[d0 & 3] + (d0 >> 2) * 128);
        const bf16x8 q = *(const LAS bf16x8*)(qx + (((d0 * 2 + hi) ^ rx) << 4));
        p = __builtin_amdgcn_mfma_f32_32x32x16_bf16(b0, q, p, 0, 0, 0);
        if (d0 < 7) __builtin_amdgcn_sched_barrier(0x0011); }
}
template <bool UP>
__device__ __forceinline__ void pv_half(f32x16 (&o)[4], int vb0, bf16x8 pa0, bf16x8 pa1) {
#define TRRD(dst, off) asm volatile("ds_read_b64_tr_b16 %0, %1 offset:%2" : "=&v"(dst) : "v"(vb0), "i"(off) : "memory")
#define PV_D0(d0) do { s16x4 l0, l1, h0, h1; constexpr int b_ = (d0) * 512 + (UP ? 8192 : 0);   \
        TRRD(l0, b_); TRRD(h0, b_ + 2048); TRRD(l1, b_ + 4096); TRRD(h1, b_ + 6144);   \
        asm volatile("s_waitcnt lgkmcnt(0)" ::: "memory"); __builtin_amdgcn_sched_barrier(0);   \
        o[d0] = __builtin_amdgcn_mfma_f32_32x32x16_bf16(pa0, (bf16x8){l0[0], l0[1], l0[2], l0[3], h0[0], h0[1], h0[2], h0[3]}, o[d0], 0, 0, 0);   \
        o[d0] = __builtin_amdgcn_mfma_f32_32x32x16_bf16(pa1, (bf16x8){l1[0], l1[1], l1[2], l1[3], h1[0], h1[1], h1[2], h1[3]}, o[d0], 0, 0, 0); } while (0)
    PV_D0(0); PV_D0(1); PV_D0(2); PV_D0(3);
#undef PV_D0
#undef TRRD
}

template <int MODE>
__device__ __forceinline__ void prompt_block(LAS char* lds, const bf16* Qh, const bf16* Kh, const bf16* Vh, const float* F2h, const bf16* Gh, bf16* Ah, int qb, float zb, int wave_) {
    int tid_ = wave_ * 64 + lane_id(); asm volatile("" : "+v"(tid_));
    const int tid = tid_, wid = __builtin_amdgcn_readfirstlane(tid >> 6), lane = tid & 63, r32 = lane & 31, hi = lane >> 5;
    const int P0 = qb * 256, qlo = P0 + wid * 32, trow = qlo + r32;
    LAS char* Vl = lds; LAS char* Kl = lds + 2 * SHM_T;
    LAS float* wsm = (LAS float*)(lds + 5 * SHM_T) + wid * 64; LAS int* flg = (LAS int*)(lds + 5 * SHM_T + 2048);
    LAS float* fbuf = (LAS float*)(lds + 5 * SHM_T + 4096);
    LAS char* Qw = lds + 5 * SHM_T + 8192 + wid * 8192;
#pragma unroll
    for (int i = 0; i < 8; ++i) { const int idx = lane + 64 * i, r = idx >> 4, c = idx & 15;
        *(LAS bf16x8*)(Qw + r * 256 + ((c ^ (r & 15)) << 4)) = *(const bf16x8*)(Qh + (size_t)(qlo + r) * 128 + c * 8); }
    const LAS char* qx = Qw + r32 * 256; const int rx = r32 & 15;
    const int NT = 4 * qb + 4;
    const int sr = tid >> 4, sc = (tid & 15) * 8;
    const int kws = KSWZ(sr, sc * 2), vst0 = v_st(sr, sc), vst1 = v_st(32 + sr, sc);
    const int vrb = (int)(unsigned)(size_t)Vl + v_rd_base(lane);
    bf16x8 sk0, sk1, sv0, sv1; float sf = 0.f;
#define PB_KB(it_) ((NT - 1 - (it_)) * 64)
#define PB_ACT(hk_) ((MODE == 0) ? ((hk_) <= qlo + 30) : ((hk_) <= qlo + 31))
#define PB_NM(hk_) ((MODE == 0) ? ((hk_) + 31 >= qlo) : ((hk_) + 31 > qlo))
    const __amdgpu_buffer_rsrc_t rK = mk_rsrc(Kh, TT * 256), rV = mk_rsrc(Vh, TT * 256);
    const int svo = sr * 256 + sc * 2;
#define PB_LOADK(it_) do { const int so_ = PB_KB(it_) * 256; sk0 = __builtin_bit_cast(bf16x8, __builtin_amdgcn_raw_buffer_load_b128(rK, svo, so_, 0)); sk1 = __builtin_bit_cast(bf16x8, __builtin_amdgcn_raw_buffer_load_b128(rK, svo, so_ + 8192, 0)); } while (0)
#define PB_LOADV(it_) do { const int so_ = PB_KB(it_) * 256; sv0 = __builtin_bit_cast(bf16x8, __builtin_amdgcn_raw_buffer_load_b128(rV, svo, so_, 0)); sv1 = __builtin_bit_cast(bf16x8, __builtin_amdgcn_raw_buffer_load_b128(rV, svo, so_ + 8192, 0)); \
        if (MODE == 1 && tid < 64) sf = F2h[PB_KB(it_) + tid]; } while (0)
#define PB_WRITEK(ko_) do { *(LAS bf16x8*)(Kl + (ko_) + kws) = sk0; *(LAS bf16x8*)(Kl + (ko_) + kws + 32 * 256) = sk1; } while (0)
#define PB_WRITEV(bf) do { *(LAS bf16x8*)(Vl + (bf) * SHM_T + vst0) = sv0; *(LAS bf16x8*)(Vl + (bf) * SHM_T + vst1) = sv1; \
        if (MODE == 1 && tid < 64) fbuf[(bf) * 64 + tid] = sf; } while (0)
    PB_LOADK(0); PB_LOADV(0); PB_WRITEK(0); PB_WRITEV(0);
    if (NT > 1) { PB_LOADK(1); PB_WRITEK(SHM_T); }
    LDS_WAIT(); __syncthreads();
    f32x16 o[4];
#pragma unroll
    for (int d = 0; d < 4; ++d) o[d] = (f32x16){0.f, 0.f, 0.f, 0.f, 0.f, 0.f, 0.f, 0.f, 0.f, 0.f, 0.f, 0.f, 0.f, 0.f, 0.f, 0.f};
    float C = 1.0f, m_run = -1e30f, l_run = 0.f;
    f32x16 pA, pB, pdum;
    if (PB_ACT(PB_KB(0) + 32)) qk_half(pA, Kl + 32 * 256, r32, hi, qx, rx);
#define PB_WEIGHTS(MASK_, PC, dq_, fk_) do {                                                                                      \
        if (MODE == 0) { float PS[8], GS[8]; const float tot = sb_step_a<1, MASK_>(PC, pdum, dq_, hi, PS, GS);                      \
            sb_step_b<1>(PC, pdum, C, PS, GS, pa0, pa1, pa2, pa3); C *= tot; }                                                      \
        else { float alpha;                                                                                                        \
            fox_weights<1, MASK_>(PC, pdum, fk_, dq_, m_run, l_run, alpha, pa0, pa1, pa2, pa3);                                     \
            if (__any(alpha < 1.0f)) { if (hi == 0) wsm[r32] = alpha;                                                               \
                _Pragma("unroll") for (int r = 0; r < 16; ++r) { const float al = wsm[crow(r, hi)];                                 \
                    _Pragma("unroll") for (int d = 0; d < 4; ++d) o[d][r] *= al; } } } } while (0)
#define PB_HALF(UP_, PC, PN, hk_, kn_, hkn_) do {                                                                                 \
        const bool actC = PB_ACT(hk_), actN = PB_ACT(hkn_);                                                                        \
        if (actC) { bf16x8 pa0, pa1, pa2, pa3; const int dq = trow - (hk_) - 4 * hi;                                               \
            const LAS f32x4* fk = (const LAS f32x4*)(fbuf + buf * 64 + (UP_ ? 32 : 0) + 4 * hi);                                   \
            if (PB_NM(hk_)) { qk_half(PN, kn_, r32, hi, qx, rx); PB_WEIGHTS(true, PC, dq, fk); }                                        \
            else            { qk_half(PN, kn_, r32, hi, qx, rx); PB_WEIGHTS(false, PC, dq, fk); }                                       \
            pv_half<UP_>(o, vrb + buf * SHM_T, pa0, pa1);                                                                           \
        } else if (actN) qk_half(PN, kn_, r32, hi, qx, rx); } while (0)
    int ko = 0;
    for (int it = 0; it < NT; ++it) {
        const int buf = it & 1, kb = PB_KB(it);
        const int ko1 = (ko == 2 * SHM_T) ? 0 : ko + SHM_T, ko2 = (ko1 == 2 * SHM_T) ? 0 : ko1 + SHM_T;
        if (it + 2 < NT) PB_LOADK(it + 2);
        if (it + 1 < NT) PB_LOADV(it + 1);
        bool skip;
        if (MODE == 0) skip = __all(C < NEG_EPS) != 0; else skip = __all(m_run + fbuf[buf * 64 + 63] > zb) != 0;
        if (!skip) {
        PB_HALF(true, pA, pB, kb + 32, Kl + ko, kb);
        PB_HALF(false, pB, pA, kb, Kl + ko1 + 32 * 256, kb - 32);
        }
        if (it + 2 < NT) PB_WRITEK(ko2);
        if (it + 1 < NT) PB_WRITEV(buf ^ 1);
        if (lane == 0) flg[buf * 8 + wid] = skip ? 1 : 0;
        LDS_WAIT(); __syncthreads();
        { const LAS int* f = flg + buf * 8; if ((f[0] & f[1]) & (f[2] & f[3]) & (f[4] & f[5]) & (f[6] & f[7])) break; }
        ko = ko1;
    }
#undef PB_HALF
#undef PB_WEIGHTS
#undef PB_KB
#undef PB_ACT
#undef PB_NM
#undef PB_LOADK
#undef PB_LOADV
#undef PB_WRITEK
#undef PB_WRITEV
    float rli[16];
    if (MODE == 1) { if (hi == 0) wsm[32 + r32] = l_run;
#pragma unroll
        for (int r = 0; r < 16; ++r) rli[r] = __builtin_amdgcn_rcpf(wsm[32 + crow(r, hi)]); }
#pragma unroll
    for (int hf = 0; hf < 2; ++hf) {
        unsigned gq[8][4];
        const unsigned gb = ((unsigned)(qlo + 4 * hi + 16 * hf) * 128u + (unsigned)r32) * 2u;
#pragma unroll
        for (int r = 0; r < 8; ++r)
#pragma unroll
            for (int d = 0; d < 4; ++d)
                asm volatile("global_load_ushort %0, %1, %2 offset:%3" : "=&v"(gq[r][d]) : "v"(gb), "s"(Gh), "n"(((r & 3) + 8 * (r >> 2)) * 256 + 64 * d) : "memory");
        __builtin_amdgcn_sched_barrier(0);
        asm volatile("s_waitcnt vmcnt(0)" ::: "memory");
        __builtin_amdgcn_sched_barrier(0);
#pragma unroll
        for (int r8 = 0; r8 < 8; ++r8) { const int r = 8 * hf + r8; const unsigned row = (unsigned)(qlo + crow(r, hi));
            const unsigned aoff = (row * 2048u + (unsigned)r32) * 2u;
#pragma unroll
            for (int d = 0; d < 4; ++d) {
                float v = o[d][r]; if (MODE == 1) v *= rli[r];
                v *= __builtin_bit_cast(float, gq[r8][d] << 16);
                const float vn = __shfl_xor(v, 1);
                const unsigned w = cvt_pk_bf16(v, vn);
                if ((r32 & 1) == 0) {
                    if (d == 0) asm volatile("global_store_dword %0, %1, %2" :: "v"(aoff), "v"(w), "s"(Ah) : "memory");
                    else if (d == 1) asm volatile("global_store_dword %0, %1, %2 offset:64" :: "v"(aoff), "v"(w), "s"(Ah) : "memory");
                    else if (d == 2) asm volatile("global_store_dword %0, %1, %2 offset:128" :: "v"(aoff), "v"(w), "s"(Ah) : "memory");
                    else asm volatile("global_store_dword %0, %1, %2 offset:192" :: "v"(aoff), "v"(w), "s"(Ah) : "memory"); } } }
    }
    LDS_WAIT(); __syncthreads();
}

template <int MODE>
__device__ __forceinline__ void sample_unit(LAS char* lds, const bf16* Qs, const float* Kc, const float* Vc, const bf16* Kn, const bf16* Vn, const float* F2, const bf16* Gs, bf16* As, const float* Kmx, int wave_) {
    int tid_ = wave_ * 64 + lane_id(); asm volatile("" : "+v"(tid_));
    const int tid = tid_, wid = __builtin_amdgcn_readfirstlane(tid >> 6), lane = tid & 63, r32 = lane & 31, hi = lane >> 5, qrow = r32 & 15;
    LAS char* Kt = lds + wid * 16384; LAS char* Vt = Kt + 8192;
    LAS float* xch = (LAS float*)(lds + XCH_OFF);
    const int vrb = (int)(unsigned)(size_t)Vt + v_rd_base(lane);
    LAS char* Qb = lds + XCH_OFF + 4096;
    if (tid < 256) { const int r = tid >> 4, c = tid & 15; *(LAS bf16x8*)(Qb + r * 256 + ((c ^ r) << 4)) = *(const bf16x8*)(Qs + (size_t)r * 128 + c * 8); }
    LDS_WAIT(); __syncthreads();
    LAS float* qnt = (LAS float*)(lds + XCH_OFF + 8192 + 1024) + wid * 64;
    LAS float* ktb = (LAS float*)(lds + XCH_OFF + 8192) + wid * 32;
    if (MODE == 1) {
        float qn = 0.f;
#pragma unroll
        for (int c = 0; c < 16; ++c) { const bf16x8 qv = *(LAS bf16x8*)(Qb + qrow * 256 + ((c ^ qrow) << 4));
#pragma unroll
            for (int e = 0; e < 8; ++e) { const float f = bf2f(qv[e]); qn += f * f; } }
        qnt[lane] = sqrtf(qn);
        const int tix = 128 - 8 * ((lane & 15) + 1) + 7 - wid;
        float kn = (tix < KN_TILES) ? Kmx[tix] : 0.f;
        kn = fmaxf(kn, __builtin_bit_cast(float, __builtin_amdgcn_update_dpp(0, __builtin_bit_cast(int, kn), 0x128, 0xf, 0xf, false)));
        kn = fmaxf(kn, __builtin_bit_cast(float, __builtin_amdgcn_update_dpp(0, __builtin_bit_cast(int, kn), 0x124, 0xf, 0xf, false)));
        kn = fmaxf(kn, __builtin_bit_cast(float, __builtin_amdgcn_update_dpp(0, __builtin_bit_cast(int, kn), 0x122, 0xf, 0xf, false)));
        kn = fmaxf(kn, __builtin_bit_cast(float, __builtin_amdgcn_update_dpp(0, __builtin_bit_cast(int, kn), 0x121, 0xf, 0xf, false)));
        if (lane < 16) { ktb[lane] = (tix < KN_TILES) ? sqrtf(kn) * 1.01f : 3.0e38f; ktb[16 + lane] = F2[tix * 32 + 31]; }
    }
    f32x16 o[4];
#pragma unroll
    for (int d = 0; d < 4; ++d) o[d] = (f32x16){0.f, 0.f, 0.f, 0.f, 0.f, 0.f, 0.f, 0.f, 0.f, 0.f, 0.f, 0.f, 0.f, 0.f, 0.f, 0.f};
    const __amdgpu_buffer_rsrc_t rk = mk_rsrc(Kc, PAST * 4096), rv = mk_rsrc(Vc, PAST * 4096);
    const int voff = hi * 4096 + r32 * 16;
    int kwa[4]; const int vw0 = v_st(hi, r32 * 4);
#pragma unroll
    for (int q = 0; q < 4; ++q) kwa[q] = KSWZ(2 * q + hi, r32 * 8);
    float R = 1.0f, m_run = -1e30f, l_run = 0.f;
    f32x4 tk[16];
#define SU_SO(rho_) ((PAST - 256 * (rho_) + 32 * (7 - wid)) * 4096)
#define SU_LOADK(rho_) do { const int so_ = SU_SO(rho_); _Pragma("unroll") for (int i = 0; i < 16; ++i) tk[i] = __builtin_bit_cast(f32x4, __builtin_amdgcn_raw_buffer_load_b128(rk, voff, so_ + i * 8192, 2)); } while (0)
#define SU_LOADV(rho_) do { const int so_ = SU_SO(rho_); _Pragma("unroll") for (int i = 0; i < 16; ++i) tk[i] = __builtin_bit_cast(f32x4, __builtin_amdgcn_raw_buffer_load_b128(rv, voff, so_ + i * 8192, 2)); } while (0)
    f32x4 fr[8];
    if (MODE == 1) {
#pragma unroll
        for (int g = 0; g < 4; ++g) fr[2 * g] = *(const f32x4*)(F2 + (PAST - 256 + 32 * (7 - wid)) + 4 * hi + 8 * g); }
    SU_LOADK(1);
    __builtin_amdgcn_sched_barrier(0);
    bool prev_v = true;
    for (int rho = 0; rho <= PAST / 256; ++rho) {
        const bool valid = (rho > 0) || (wid == 0);
        const int s0 = (rho == 0) ? PAST : PAST - 256 * rho + 32 * (7 - wid);
        f32x16 p0, p1; bf16x8 pa0, pa1, pa2, pa3; float PS[8], GS[8]; float tot = 1.0f; bool need_v = valid, pre_v = false;
        if (valid) {
            if (rho == 0) {
#pragma unroll
                for (int i = 0; i < 4; ++i) { const int idx = lane + 64 * i, row = idx >> 4, ch = idx & 15;
                    const bf16x8 kv = *(const bf16x8*)(Kn + (size_t)row * 128 + ch * 8);
                    const bf16x8 z = (bf16x8){0, 0, 0, 0, 0, 0, 0, 0};
                    *(LAS bf16x8*)(Kt + KSWZ(row, ch * 16)) = kv; *(LAS bf16x8*)(Kt + KSWZ(row + 16, ch * 16)) = z; }
            } else {
#pragma unroll
                for (int i = 0; i < 16; ++i) { u32x2 w; w.x = cvt_pk_bf16(tk[i][0], tk[i][1]); w.y = cvt_pk_bf16(tk[i][2], tk[i][3]); *(LAS u32x2*)(Kt + kwa[i & 3] + (i >> 2) * 2048) = w; }
                __builtin_amdgcn_sched_barrier(0);
                pre_v = (MODE == 0) || prev_v;
                if (pre_v) SU_LOADV(rho);
                __builtin_amdgcn_sched_barrier(0);
            }
            qkt_qlds(p0, Kt, Qb, r32, hi, qrow);
            const int dq = qrow - 4 * hi;
            if (MODE == 0) { if (rho == 0) tot = sb_step_a<1, true>(p0, p1, dq, hi, PS, GS); else tot = sb_step_a<1, false>(p0, p1, dq, hi, PS, GS); }
            else { float alpha, ps;
                if (rho == 0) ps = fox_weights<1, true>(p0, p1, (const f32x4*)(F2 + s0 + 4 * hi), dq, m_run, l_run, alpha, pa0, pa1, pa2, pa3);
                else { ps = fox_weights<1, false>(p0, p1, (const f32x4*)fr, dq, m_run, l_run, alpha, pa0, pa1, pa2, pa3);
                    if (rho < PAST / 256) {
#pragma unroll
                        for (int g = 0; g < 4; ++g) fr[2 * g] = *(const f32x4*)(F2 + s0 - 256 + 4 * hi + 8 * g); } }
                need_v = __any(ps != 0.0f) != 0;
                if (__any(alpha < 1.0f)) { LAS float* al = xch + 768 + wid * 32; if (hi == 0) al[r32] = alpha;
#pragma unroll
                    for (int r = 0; r < 16; ++r) { const float a_ = al[crow(r, hi)];
#pragma unroll
                        for (int d = 0; d < 4; ++d) o[d][r] *= a_; } }
            }
        }
        if (MODE == 0) {
            LAS float* xr = xch + (rho & 1) * 256;
            if (hi == 0) xr[wid * 32 + r32] = tot;
            LDS_WAIT(); __builtin_amdgcn_s_barrier(); asm volatile("" ::: "memory");
            float Cin = R;
#pragma unroll
            for (int w = 0; w < 8; ++w) { const float tw = xr[w * 32 + r32]; if (w < wid) Cin *= tw; R *= tw; }
            if (valid) sb_step_b<1>(p0, p1, Cin, PS, GS, pa0, pa1, pa2, pa3);
        }
        const bool more = (rho < PAST / 256) && !(MODE == 0 && rho > 0 && __all(R < NEG_EPS)) && !(MODE == 1 && rho > 0 && __all(qnt[lane] * ktb[rho & 15] - ktb[16 + (rho & 15)] - m_run < -NEG_BITS));
        if (need_v) {
            if (rho == 0) {
#pragma unroll
                for (int i = 0; i < 4; ++i) { const int idx = lane + 64 * i, row = idx >> 4, ch = idx & 15;
                    const bf16x8 vv = *(const bf16x8*)(Vn + (size_t)row * 128 + ch * 8);
                    const bf16x8 z = (bf16x8){0, 0, 0, 0, 0, 0, 0, 0};
                    *(LAS bf16x8*)(Vt + v_st(row, ch * 8)) = vv; *(LAS bf16x8*)(Vt + v_st(row + 16, ch * 8)) = z; }
            } else {
                if (!pre_v) SU_LOADV(rho);
#pragma unroll
                for (int i = 0; i < 16; ++i) { u32x2 w; w.x = cvt_pk_bf16(tk[i][0], tk[i][1]); w.y = cvt_pk_bf16(tk[i][2], tk[i][3]); *(LAS u32x2*)(Vt + vw0 + ((i >> 1) & 1) * 2048 + (i & 1) * 128 + (i >> 3) * 4096 + ((i >> 2) & 1) * 256) = w; }
            }
            __builtin_amdgcn_sched_barrier(0);
            if (rho > 0 && more) SU_LOADK(rho + 1);
            __builtin_amdgcn_sched_barrier(0);
            pv_tile<1>(o, vrb, pa0, pa1, pa2, pa3);
        } else if (rho > 0 && more) SU_LOADK(rho + 1);
        if (rho > 0) prev_v = need_v;
        if (!more) break;
    }
#undef SU_SO
#undef SU_LOADK
#undef SU_LOADV
    LDS_WAIT(); __syncthreads();
    int tid2 = wave_ * 64 + lane_id(); asm volatile("" : "+v"(tid2));
    { const int l2 = tid2 & 63, c2 = l2 & 31, h2 = l2 >> 5;
    if (MODE == 1 && h2 == 0 && c2 < 16) { xch[512 + wid * 16 + c2] = m_run; xch[640 + wid * 16 + c2] = l_run; }
    LAS float* Op = (LAS float*)(lds + wid * 16384) + 4 * h2 * 128 + c2;
#pragma unroll
    for (int d = 0; d < 4; ++d)
#pragma unroll
        for (int r = 0; r < 8; ++r) Op[((r & 3) + 8 * (r >> 2)) * 128 + d * 32] = o[d][r]; }
    LDS_WAIT(); __syncthreads();
    {
        const int row = tid2 >> 5, col = (tid2 & 31) * 4;
        f32x4 num = (f32x4){0.f, 0.f, 0.f, 0.f}; float den = 0.f, M = -1e30f;
        const LAS float* xm = xch + 512 + row;
        if (MODE == 1) {
#pragma unroll 1
            for (int w = 0; w < 8; ++w) M = fmaxf(M, xm[w * 16]); }
        const LAS char* opb = lds + (row * 128 + col) * 4;
#pragma unroll 1
        for (int w = 0; w < 8; ++w) { const f32x4 v = *(const LAS f32x4*)(opb + w * 16384);
            if (MODE == 1) { const float f = __builtin_amdgcn_exp2f(xm[w * 16] - M); num += v * f; den += f * xm[128 + w * 16]; } else num += v; }
        if (MODE == 1) num = num * (1.0f / den);
        const u32x2 gw = *(const u32x2*)(Gs + (size_t)row * 128 + col);
        u32x2 ow; ow.x = cvt_pk_bf16(num[0] * bf_lo(gw.x), num[1] * bf_hi(gw.x)); ow.y = cvt_pk_bf16(num[2] * bf_lo(gw.y), num[3] * bf_hi(gw.y));
        *(u32x2*)(As + (size_t)row * 2048 + col) = ow;
    }
    LDS_WAIT(); __syncthreads();
}
}

struct Args { const float* in[15]; float* out; unsigned char* ws; int ph_lo, ph_hi, li, pad; };

__global__ void __launch_bounds__(512, 2) fwd(Args args) {
    extern __shared__ __attribute__((aligned(16))) unsigned char lds_raw[];
    LAS unsigned char* lds = (LAS unsigned char*)lds_raw;
    const int wave = __builtin_amdgcn_readfirstlane((int)threadIdx.x >> 6);
#define lane (lane_id())
#define tid (wave * 64 + lane_id())
    const int G = gridDim.x;
    Ptrs P;
    P.xp = args.in[0]; P.xs = args.in[1]; P.csbk = args.in[2]; P.csbv = args.in[3]; P.cfxk = args.in[4]; P.cfxv = args.in[5]; P.cflf = args.in[6]; P.normw = args.in[7];
    P.win = args.in[8]; P.bfor = args.in[9]; P.qnw = args.in[10]; P.knw = args.in[11]; P.wbsb = args.in[12]; P.wbfx = args.in[13]; P.wout = args.in[14];
    P.out = args.out; P.ws = args.ws;
    volatile LAS unsigned* MISC = (volatile LAS unsigned*)(lds + MISC_OFF);
    if (tid < 64) MISC[tid] = 0u;
    __syncthreads();
    unsigned* ctl = (unsigned*)(P.ws + WS_CTL);
    XcdBarrier bar; bar.bar = ctl + args.li * 4096; bar.x = 0; bar.st = nullptr; bar.wave = wave;
    if (N_LAUNCHES != N_PHASES) bar = xcd_barrier_post(ctl + args.li * 4096, MISC + 8, wave);
    const int lo = args.ph_lo, hi_ = args.ph_hi;
#define IN(k) (lo <= (k) && (k) < hi_)
#define BOTH(k) (IN(k) && IN((k) + 1))
#define GRID_BAR() do { if (N_LAUNCHES != N_PHASES) xcd_barrier(bar); } while (0)

    if (IN(0)) { p0_prologue(P, lds, blockIdx.x * 8 + wave, G * 8, wave, lane, tid);
        if (PROBE_DOUBLE == 0) { __syncthreads(); p0_prologue(P, lds, blockIdx.x * 8 + wave, G * 8, wave, lane, tid); }
        if (BOTH(0)) GRID_BAR(); }

    if (IN(1)) {
        pg8::Gemm g{(const bf16*)(P.ws + WS_H), (const bf16*)(P.ws + WS_WIN), TT, NPROJ, DM};
        pg8::StaticOrder S; S.init(TT, NPROJ, G, (int)blockIdx.x, WGM_P1);
        pg8::EpiInProj E{P.ws, P.out, P.qnw, P.knw, (LAS float*)(lds + XCH_OFF)};
        pg8::gemm_phase<pg8::EpiInProj, pg8::StaticOrder, true, true>(lds, g, S, E, wave);
        if (PROBE_DOUBLE == 1) { GRID_BAR(); pg8::gemm_phase<pg8::EpiInProj, pg8::StaticOrder, true, true>(lds, g, S, E, wave); }
        { const int ex = ((TT / 256) * (NPROJ / 256)) % G, nside = (ex > 0 && ex < G) ? G - ex : G, sid = (ex > 0 && ex < G) ? (int)blockIdx.x - ex : (int)blockIdx.x;
          if (sid >= 0) { __syncthreads();
              for (int id = sid; id < 8 + NBAT * NH; id += nside) scan_seq(P, lds, id, tid);
              p1_side_weights(P, lds, sid * 8 + wave, nside * 8, wave, lane);
              p1_side_knorm(P, sid * 8 + wave, nside * 8, lane); } }
        if (BOTH(1)) GRID_BAR();
    }

    if (IN(2)) {
        const bf16* ACT = (const bf16*)(P.ws + WS_ACT); constexpr size_t AS = ACT_STRIDE / 2;
        bf16* ACAT = (bf16*)(P.ws + WS_ACAT);
        LAS int* slot = (LAS int*)(lds + MISC_OFF + 64);
        float zb;
        { float a = fmaxf(fabsf(P.qnw[lane]), fabsf(P.qnw[lane + 64])), b = fmaxf(fabsf(P.knw[lane]), fabsf(P.knw[lane + 64]));
#pragma unroll
          for (int o = 1; o < 64; o <<= 1) { a = fmaxf(a, __shfl_xor(a, o)); b = fmaxf(b, __shfl_xor(b, o)); }
          zb = __builtin_bit_cast(float, __builtin_amdgcn_readfirstlane(__builtin_bit_cast(unsigned, 128.0f * a * b * QSCALE * 1.02f + NEG_BITS))); }
#define DQ_NEXT(q, var) do { if (tid == 0) *slot = (int)__hip_atomic_fetch_add(ctl + CW_QUEUE + 64 * (q), 1u, __ATOMIC_RELAXED, __HIP_MEMORY_SCOPE_AGENT); LDS_WAIT(); __syncthreads(); var = *slot; __syncthreads(); } while (0)
        { constexpr int qo = 0;
        if ((((int)blockIdx.x >> 3) & 1) == 0) { const int u = ((int)blockIdx.x >> 4) * 8 + ((int)blockIdx.x & 7);
            const int b = u >> 3, h = u & 7;
            const size_t ro = ((size_t)h * TT + TP + 16 * b) * 128, co = ((size_t)b * PAST * NH + h) * HD;
            att::sample_unit<1>((LAS char*)lds, ACT + A_QFX * AS + ro, P.cfxk + co, P.cfxv + co, ACT + A_KFX * AS + ro, ACT + A_VFX * AS + ro,
                                (const float*)(P.ws + WS_F2S) + (size_t)(b * 8 + h) * KT, ACT + A_GFX * AS + ro, ACAT + (size_t)(TP + 16 * b) * 2048 + 1024 + 128 * h, (const float*)(P.ws + WS_KMX) + (size_t)(b * 8 + h) * 128, wave); }
#define DQ_HEADS(QB, cur, u, hsel) do { if (wave == 0) { int hs_ = (cur), uu_ = 32;                                                                              \
            for (;;) { unsigned v_ = 0u; if (lane == 0) v_ = __hip_atomic_fetch_add(ctl + CW_QUEUE + 64 * ((QB) + hs_), 1u, __ATOMIC_RELAXED, __HIP_MEMORY_SCOPE_AGENT);   \
                uu_ = __builtin_amdgcn_readfirstlane((int)v_); if (uu_ < 32) break;                                                                                 \
                unsigned c_ = 32u; if (lane < 8) c_ = __hip_atomic_load(ctl + CW_QUEUE + 64 * ((QB) + lane), __ATOMIC_RELAXED, __HIP_MEMORY_SCOPE_AGENT);               \
                const unsigned m_ = (unsigned)__ballot(c_ < 32u) & 0xffu; if (m_ == 0u) { hs_ = -1; break; }                                                       \
                const unsigned rot_ = ((m_ >> home) | (m_ << (8 - home))) & 0xffu; hs_ = (home + __builtin_ctz(rot_)) & 7; }                                       \
            if (lane == 0) { slot[0] = uu_; slot[1] = hs_; } }                                                                                                     \
        LDS_WAIT(); __syncthreads(); u = slot[0]; hsel = slot[1]; __syncthreads(); } while (0)
        const int home = (int)blockIdx.x & 7;
        { int cur = home;
          for (;;) { int u, h; DQ_HEADS(16, cur, u, h); if (h < 0) break; cur = h; const size_t ho = (size_t)h * TT * 128;
              att::prompt_block<1>((LAS char*)lds, ACT + A_QFX * AS + ho, ACT + A_KFX * AS + ho, ACT + A_VFX * AS + ho, (const float*)(P.ws + WS_F2P) + (size_t)h * TP, ACT + A_GFX * AS + ho, ACAT + 1024 + 128 * h, 31 - u, zb, wave); } }
        { int cur = home;
          for (;;) { int u, h; DQ_HEADS(24, cur, u, h); if (h < 0) break; cur = h; const size_t ho = (size_t)h * TT * 128;
              att::prompt_block<0>((LAS char*)lds, ACT + A_QSB * AS + ho, ACT + A_KSB * AS + ho, ACT + A_VSB * AS + ho, (const float*)(P.ws + WS_F2P), ACT + A_GSB * AS + ho, ACAT + 128 * h, 31 - u, zb, wave); } }
#undef DQ_HEADS
        for (;;) { int u; DQ_NEXT(qo + 3, u); if (u >= NBAT * NH) break;
            const int b = u >> 3, h = u & 7;
            const size_t ro = ((size_t)h * TT + TP + 16 * b) * 128, co = ((size_t)b * PAST * NH + h) * HD;
            att::sample_unit<0>((LAS char*)lds, ACT + A_QSB * AS + ro, P.csbk + co, P.csbv + co, ACT + A_KSB * AS + ro, ACT + A_VSB * AS + ro,
                                (const float*)(P.ws + WS_F2S), ACT + A_GSB * AS + ro, ACAT + (size_t)(TP + 16 * b) * 2048 + 128 * h, nullptr, wave); }
        }
#undef DQ_NEXT
        if (BOTH(2)) GRID_BAR();
    }
    if (IN(3)) {
        pg8::Gemm g{(const bf16*)(P.ws + WS_ACAT), (const bf16*)(P.ws + WS_WB), TP, DM, DM};
        pg8::StaticOrder S; S.init(TP, DM, G, (int)blockIdx.x, WGM_P3);
        for (int u = blockIdx.x; u < 256; u += G)
            mini_gemm<0>(lds, (const bf16*)(P.ws + WS_ACAT) + (size_t)TP * 2048, (const bf16*)(P.ws + WS_WB), u, wave, lane, tid, (const bf16*)(P.ws + WS_MSIG) + (size_t)TP * 4096, (bf16*)(P.ws + WS_MRG) + (size_t)TP * 2048, nullptr, nullptr);
        pg8::EpiMerge E{(const bf16*)(P.ws + WS_MSIG), (bf16*)(P.ws + WS_MRG)};
        pg8::gemm_phase<pg8::EpiMerge, pg8::StaticOrder, true, true>(lds, g, S, E, wave);
        if (PROBE_DOUBLE == 3) { GRID_BAR(); pg8::gemm_phase<pg8::EpiMerge, pg8::StaticOrder, true, true>(lds, g, S, E, wave); }
        if (BOTH(3)) GRID_BAR();
    }

    if (IN(4)) {
        pg8::Gemm g{(const bf16*)(P.ws + WS_MRG), (const bf16*)(P.ws + WS_WO), TP, DM, DM};
        pg8::StaticOrder S; S.init(TP, DM, G, (int)blockIdx.x, WGM_P4);
        for (int u = blockIdx.x; u < 256; u += G)
            mini_gemm<1>(lds, (const bf16*)(P.ws + WS_MRG) + (size_t)TP * 2048, (const bf16*)(P.ws + WS_WO), u, wave, lane, tid, nullptr, nullptr, P.xs, P.out + O_YS);
        pg8::EpiOut E{P.xp, P.xs, P.out};
        pg8::gemm_phase<pg8::EpiOut, pg8::StaticOrder, true, true>(lds, g, S, E, wave);
    }
#undef IN
#undef BOTH
#undef GRID_BAR
#undef lane
#undef tid
}

extern "C" void kernel_launch(void* const* d_in, const int* in_sizes, int n_in, void* d_out, int out_size, void* d_ws, size_t ws_size, hipStream_t stream) {
    static int grid = 0;
    if (grid == 0) {
        if (n_in != 15 || out_size != (int)O_END || ws_size < WS_END) { fprintf(stderr, "kernel_launch: unexpected shapes (n_in %d, out %d, ws %zu)\n", n_in, out_size, ws_size); grid = -1; return; }
        int dev = 0, cus = 0, per_cu = 0;
        if (hipGetDevice(&dev) != hipSuccess || hipDeviceGetAttribute(&cus, hipDeviceAttributeMultiprocessorCount, dev) != hipSuccess) { grid = -1; return; }
        if (hipFuncSetAttribute((const void*)fwd, hipFuncAttributeMaxDynamicSharedMemorySize, LDS_BYTES) != hipSuccess) { fprintf(stderr, "kernel_launch: hipFuncSetAttribute failed\n"); grid = -1; return; }
        if (hipOccupancyMaxActiveBlocksPerMultiprocessor(&per_cu, (const void*)fwd, 512, LDS_BYTES) != hipSuccess || per_cu < 1) fprintf(stderr, "kernel_launch: occupancy query reports %d\n", per_cu);
        (void)hipGetLastError();
        grid = cus;
    }
    if (grid < 0) return;
    if (hipMemsetAsync((char*)d_ws + WS_CTL, 0, CTL_ZERO_BYTES, stream) != hipSuccess) return;
    Args a{};
    for (int i = 0; i < 15; ++i) a.in[i] = (const float*)d_in[i];
    a.out = (float*)d_out; a.ws = (unsigned char*)d_ws;
    for (int li = 0; li < N_LAUNCHES; ++li) {
        if (N_LAUNCHES == N_PHASES) { a.ph_lo = li; a.ph_hi = li + 1; } else { a.ph_lo = 0; a.ph_hi = N_PHASES; }
        a.li = li; a.pad = 0;
        hipLaunchKernelGGL(fwd, dim3(grid), dim3(512), LDS_BYTES, stream, a);
        const hipError_t le = hipPeekAtLastError();
        if (le != hipSuccess) { fprintf(stderr, "kernel_launch: launch %d failed: %s\n", li, hipGetErrorName(le)); break; }
    }
}
```

```cpp
#include <hip/hip_runtime.h>
#include <cstdio>
#include <cstdint>

#ifndef MK_N_LAUNCHES
#define MK_N_LAUNCHES 1
#endif
#ifndef PROBE_DOUBLE
#define PROBE_DOUBLE -1
#endif
constexpr int N_PHASES = 5;
constexpr int N_LAUNCHES = MK_N_LAUNCHES;

#define GAS __attribute__((address_space(1)))
#define LAS __attribute__((address_space(3)))
typedef unsigned short bf16;
typedef short bf16x8 __attribute__((ext_vector_type(8)));
typedef short s16x4 __attribute__((ext_vector_type(4)));
typedef float f32x4 __attribute__((ext_vector_type(4)));
typedef float f32x16 __attribute__((ext_vector_type(16)));
typedef unsigned u32x4 __attribute__((ext_vector_type(4)));
typedef unsigned u32x2 __attribute__((ext_vector_type(2)));

constexpr int DM = 2048, TP = 8192, NBAT = 16, NSEQ = 16, PAST = 4096, NH = 8, HD = 128, WB = 1024;
constexpr int TS = NBAT * NSEQ;
constexpr int TT = TP + TS;
constexpr int DIN = 12296, NPROJ = 12288;
constexpr int KT = PAST + NSEQ;
constexpr float RMS_EPS = 1e-6f;
constexpr float LOG2E = 1.4426950408889634f;
constexpr float QSCALE = 0.08838834764831845f * 1.4426950408889634f;

constexpr size_t O_YP = 0, O_YS = 16777216, O_PSBK = 17301504, O_PSBV = 25690112, O_PFXK = 34078720, O_PFXV = 42467328, O_PLF = 50855936,
                 O_SSBK = 50921472, O_SSBV = 51183616, O_SFXK = 51445760, O_SFXV = 51707904, O_SLF = 51970048, O_END = 51972096;

constexpr size_t MiB = 1u << 20;
constexpr size_t WS_CTL = 0, CTL_ZERO_BYTES = 1 * MiB;
constexpr int CW_QUEUE = 32768;
constexpr size_t WS_WIN = 2 * MiB;
constexpr size_t WS_WB = 50 * MiB;
constexpr size_t WS_WO = 58 * MiB;
constexpr size_t WS_H = 66 * MiB;
constexpr size_t WS_ACT = 99 * MiB, ACT_STRIDE = 17 * MiB;
constexpr size_t WS_MSIG = 235 * MiB;
constexpr size_t WS_ACAT = 301 * MiB;
constexpr size_t WS_MRG = 334 * MiB;
constexpr size_t WS_F2P = 367 * MiB;
constexpr size_t WS_F2S = 368 * MiB;
constexpr size_t WS_KMX = 372 * MiB;
constexpr size_t WS_END = 373 * MiB;
constexpr int KN_TILES = 96;
constexpr int WGM_P1 = 3, WGM_P3 = 4, WGM_P4 = 4;
constexpr float NEG_BITS = 64.0f, NEG_EPS = 5.0e-20f;
enum { A_QSB = 0, A_KSB, A_VSB, A_GSB, A_QFX, A_KFX, A_VFX, A_GFX };

constexpr int LDS_BYTES = 163840;
constexpr int XCH_OFF = 131072;
constexpr int MISC_OFF = 163328;

#define LDS_WAIT() asm volatile("s_waitcnt lgkmcnt(0)" ::: "memory")
#define VM_WAIT() asm volatile("s_waitcnt vmcnt(0)" ::: "memory")
__device__ __forceinline__ unsigned cvt_pk_bf16(float lo, float hi) { unsigned r; asm volatile("v_cvt_pk_bf16_f32 %0, %1, %2" : "=v"(r) : "v"(lo), "v"(hi)); return r; }
__device__ __forceinline__ float bf_lo(unsigned w) { return __builtin_bit_cast(float, w << 16); }
__device__ __forceinline__ float bf_hi(unsigned w) { return __builtin_bit_cast(float, w & 0xffff0000u); }
__device__ __forceinline__ float bf2f(bf16 v) { return __builtin_bit_cast(float, (unsigned)v << 16); }
__device__ __forceinline__ float fast_sigmoid(float v) { return __builtin_amdgcn_rcpf(1.0f + __builtin_amdgcn_exp2f(-v * LOG2E)); }

__device__ __forceinline__ int lane_id() { int r; asm volatile("v_mbcnt_lo_u32_b32 %0, -1, 0\n\tv_mbcnt_hi_u32_b32 %0, -1, %0" : "=v"(r)); return r; }
namespace pg8 {
constexpr int BM = 256, BK = 64, HALF = 128, HTB = HALF * BK * 2, STAGE_BYTES = 8 * HTB, NXCD = 8;
__host__ __device__ __forceinline__ int lds_byte(int r, int c) { const int st = (r >> 4) * 2 + (c >> 5), rr = r & 15, cc = c & 31, ob = rr * 64 + cc * 2; return st * 1024 + (ob ^ (((ob >> 9) & 1) << 5)); }
__host__ __device__ __forceinline__ void stage_rc(int b, int& R, int& C) { const int st = b / 1024, sb = b % 1024, swz = sb ^ (((sb >> 9) & 1) << 5); R = (st >> 1) * 16 + swz / 64; C = (st & 1) * 32 + (swz % 64) / 2; }
__host__ __device__ __forceinline__ int perm32(int rho) { const int n = rho >> 4, i = rho & 15; return 8 * (i >> 2) + 4 * n + (i & 3); }

struct Unit { int pm, pn; };
struct Gemm { const bf16* A; const bf16* Bt; int M, N, K; };

struct StaticOrder {
    int nM, nN, nwg, G, c, WGM;
    __host__ __device__ void init(int M, int N, int G_, int c_, int wgm_) { nM = M / BM; nN = N / BM; nwg = nM * nN; G = G_; c = c_; WGM = wgm_; }
    __host__ __device__ bool next(int i, Unit& u) const {
        const long L = (long)i * G + c; if (L >= nwg) return false;
        int wgid = (int)L; { const int q = nwg / NXCD, r = nwg % NXCD, xcd = wgid % NXCD, off = wgid / NXCD; wgid = (xcd < r ? xcd * (q + 1) : r * (q + 1) + (xcd - r) * q) + off; }
        const int nig = WGM * nN, gid = wgid / nig, fm = gid * WGM, gsz = (nM - fm) < WGM ? (nM - fm) : WGM;
        u.pm = fm + ((wgid % nig) % gsz); u.pn = (wgid % nig) / gsz; return true;
    }
    __device__ __forceinline__ void a_ready(const Unit&) const {}
    __device__ __forceinline__ void done(const Unit&) const {}
};


struct EpiInProj {
    static constexpr bool PERM = true, AFTER_DRAIN = false, MIDK = false;
    unsigned char* ws; float* out; const float* qnw; const float* knw; LAS float* xch;
    __device__ __forceinline__ void operator()(f32x4 (&acc)[2][2][4][2], const Unit& u, int wr, int wc, int fr, int fq) const {
        const int grp = u.pn >> 2;
        const int rowl0 = wr * 64 + fr, colq = wc * 32 + 8 * fq;
        const bool sample = (u.pm >= TP / 256);
        if (grp == 4 || grp == 5) {
            const float* nw = (grp == 4) ? qnw : knw;
            const f32x4 w0 = *(const f32x4*)(nw + colq), w1 = *(const f32x4*)(nw + colq + 4);
#pragma unroll
            for (int ai = 0; ai < 2; ++ai)
#pragma unroll
                for (int m = 0; m < 4; ++m)
#pragma unroll
                    for (int bj = 0; bj < 2; ++bj) {
                        const f32x4 a = acc[ai][bj][m][0], b = acc[ai][bj][m][1];
                        float s = (a[0] * a[0] + a[1] * a[1]) + (a[2] * a[2] + a[3] * a[3]) + (b[0] * b[0] + b[1] * b[1]) + (b[2] * b[2] + b[3] * b[3]);
                        s += __shfl_xor(s, 16); s += __shfl_xor(s, 32);
                        if (fq == 0) xch[(ai * 128 + rowl0 + 16 * m) * 8 + bj * 4 + wc] = s;
                    }
            LDS_WAIT(); __builtin_amdgcn_s_barrier(); asm volatile("" ::: "memory");
            const float post = (grp == 4) ? QSCALE : 1.0f;
#pragma unroll
            for (int ai = 0; ai < 2; ++ai)
#pragma unroll
                for (int m = 0; m < 4; ++m)
#pragma unroll
                    for (int bj = 0; bj < 2; ++bj) {
                        const f32x4 t = *(const LAS f32x4*)(xch + (ai * 128 + rowl0 + 16 * m) * 8 + bj * 4);
                        const float tot = (t[0] + t[1]) + (t[2] + t[3]);
                        const float rs = __builtin_amdgcn_rsqf(tot * (1.0f / 128.0f) + RMS_EPS) * post;
                        acc[ai][bj][m][0] = acc[ai][bj][m][0] * rs * w0; acc[ai][bj][m][1] = acc[ai][bj][m][1] * rs * w1;
                    }
        }
        bf16* bdst; int bld; int bcol0; float* fdst = nullptr; int mode = 0;
        if (grp < 8) { bdst = (bf16*)(ws + WS_ACT + (size_t)grp * ACT_STRIDE); bld = 1024; bcol0 = (u.pn & 3) * 256;
            if (grp == 0) mode = 1; else if (grp == 3 || grp == 7) mode = 2;
            if (grp == 1) fdst = out + (sample ? O_SSBK : O_PSBK); else if (grp == 2) fdst = out + (sample ? O_SSBV : O_PSBV);
            else if (grp == 5) fdst = out + (sample ? O_SFXK : O_PFXK); else if (grp == 6) fdst = out + (sample ? O_SFXV : O_PFXV);
        } else { bdst = (bf16*)(ws + WS_MSIG); bld = 4096; bcol0 = (u.pn - 32) * 256; mode = 3; }
        const int frow_off = sample ? TP : 0;
#pragma unroll
        for (int ai = 0; ai < 2; ++ai)
#pragma unroll
            for (int m = 0; m < 4; ++m) {
                const int row = u.pm * 256 + ai * 128 + rowl0 + 16 * m;
#pragma unroll
                for (int bj = 0; bj < 2; ++bj) {
                    f32x4 v0 = acc[ai][bj][m][0], v1 = acc[ai][bj][m][1];
                    const int col = bcol0 + bj * 128 + colq;
                    if (fdst) { float* fp = fdst + (size_t)(row - frow_off) * 1024 + col; *(f32x4*)fp = v0; *(f32x4*)(fp + 4) = v1; }
                    if (mode == 1) { v0 = v0 * QSCALE; v1 = v1 * QSCALE; }
                    else if (mode == 2) {
#pragma unroll
                        for (int j = 0; j < 4; ++j) { v0[j] = v0[j] * fast_sigmoid(v0[j]); v1[j] = v1[j] * fast_sigmoid(v1[j]); } }
                    else if (mode == 3) {
#pragma unroll
                        for (int j = 0; j < 4; ++j) { v0[j] = fast_sigmoid(v0[j]); v1[j] = fast_sigmoid(v1[j]); } }
                    u32x4 w; w.x = cvt_pk_bf16(v0[0], v0[1]); w.y = cvt_pk_bf16(v0[2], v0[3]); w.z = cvt_pk_bf16(v1[0], v1[1]); w.w = cvt_pk_bf16(v1[2], v1[3]);
                    if (grp < 8) *(u32x4*)(bdst + ((size_t)(((u.pn & 3) * 2 + bj) * TT + row)) * 128 + colq) = w;
                    else if (sample) *(u32x4*)(bdst + (size_t)row * bld + col) = w;
                    else *(u32x4*)(bdst + (size_t)(u.pm * 16 + (u.pn - 32)) * 65536 + (size_t)((ai * 4 + m) * 2 + bj) * 4096 + (size_t)(((wr * 4 + wc) * 64 + fq * 16 + fr) * 8)) = w;
                }
            }
    }
};

struct EpiMerge {
    static constexpr bool PERM = true, AFTER_DRAIN = false, MIDK = true;
    const bf16* msig; bf16* mrg;
    template <bool FINAL>
    __device__ __forceinline__ void apply(f32x4 (&acc)[2][2][4][2], const Unit& u, int wr, int wc, int fr, int fq) const {
        const int rowl0 = wr * 64 + fr, colq = wc * 32 + 8 * fq;
        int pm_ = u.pm; asm volatile("" : "+s"(pm_));
#pragma unroll
        for (int ai = 0; ai < 2; ++ai)
#pragma unroll
            for (int m = 0; m < 4; ++m) {
                const int row = pm_ * 256 + ai * 128 + rowl0 + 16 * m;
#pragma unroll
                for (int bj = 0; bj < 2; ++bj) {
                    const int col = u.pn * 256 + bj * 128 + colq;
                    const bf16* gt = msig + (size_t)(pm_ * 16 + u.pn) * 65536 + (size_t)((ai * 4 + m) * 2 + bj) * 4096 + (size_t)(((wr * 4 + wc) * 64 + fq * 16 + fr) * 8);
                    const u32x4 gf = *(const u32x4*)(gt + (size_t)8 * 65536);
                    float f[8] = {bf_lo(gf.x), bf_hi(gf.x), bf_lo(gf.y), bf_hi(gf.y), bf_lo(gf.z), bf_hi(gf.z), bf_lo(gf.w), bf_hi(gf.w)};
#pragma unroll
                    for (int j = 0; j < 8; ++j) f[j] = fmaxf(f[j], 1e-30f);
                    if (!FINAL) {
                        const u32x4 gs = *(const u32x4*)gt;
                        const float s[8] = {bf_lo(gs.x), bf_hi(gs.x), bf_lo(gs.y), bf_hi(gs.y), bf_lo(gs.z), bf_hi(gs.z), bf_lo(gs.w), bf_hi(gs.w)};
#pragma unroll
                        for (int j = 0; j < 4; ++j) { acc[ai][bj][m][0][j] *= s[j] * __builtin_amdgcn_rcpf(f[j]); acc[ai][bj][m][1][j] *= s[4 + j] * __builtin_amdgcn_rcpf(f[4 + j]); }
                    } else {
                        const f32x4 v0 = acc[ai][bj][m][0], v1 = acc[ai][bj][m][1];
                        u32x4 w; w.x = cvt_pk_bf16(v0[0] * f[0], v0[1] * f[1]); w.y = cvt_pk_bf16(v0[2] * f[2], v0[3] * f[3]);
                        w.z = cvt_pk_bf16(v1[0] * f[4], v1[1] * f[5]); w.w = cvt_pk_bf16(v1[2] * f[6], v1[3] * f[7]);
                        *(u32x4*)(mrg + (size_t)row * 2048 + col) = w;
                    }
                    asm volatile("" ::: "memory");
                }
            }
    }
    __device__ __forceinline__ void mid(f32x4 (&acc)[2][2][4][2], const Unit& u, int wr, int wc, int fr, int fq) const { apply<false>(acc, u, wr, wc, fr, fq); }
    __device__ __forceinline__ void operator()(f32x4 (&acc)[2][2][4][2], const Unit& u, int wr, int wc, int fr, int fq) const { apply<true>(acc, u, wr, wc, fr, fq); }
};

struct EpiOut {
    static constexpr bool PERM = false, AFTER_DRAIN = false, MIDK = false;
    const float* xp; const float* xs; float* y;
    __device__ __forceinline__ void operator()(f32x4 (&acc)[2][2][4][2], const Unit& u, int wr, int wc, int fr, int fq) const {
        const int rowl0 = wr * 64 + fr, colq = wc * 32 + 4 * fq;
#pragma unroll
        for (int ai = 0; ai < 2; ++ai)
#pragma unroll
            for (int m = 0; m < 4; ++m) {
                const int row = u.pm * 256 + ai * 128 + rowl0 + 16 * m;
                const float* xr = (row < TP) ? xp + (size_t)row * DM : xs + (size_t)(row - TP) * DM;
                float* yr = y + (size_t)row * DM;
#pragma unroll
                for (int bj = 0; bj < 2; ++bj)
#pragma unroll
                    for (int n = 0; n < 2; ++n) { const int c = u.pn * 256 + bj * 128 + colq + 16 * n; *(f32x4*)(yr + c) = acc[ai][bj][m][n] + *(const f32x4*)(xr + c); }
                asm volatile("" ::: "memory");
            }
    }
};

template <class Epi, class Sched, bool ALIGN_EPI = false, bool SP2 = false>
__device__ __forceinline__ void gemm_phase(LAS unsigned char* lds, const Gemm g, const Sched& S, const Epi& E, int wave_) {
    const int wid = wave_, lane = lane_id(), tid = wid * 64 + lane, wr = wid >> 2, wc = wid & 3, fr = lane & 15, fq = lane >> 4;
    const int K = g.K, nt = K / BK;
    unsigned voffA[2], voffB[2];
#pragma unroll
    for (int i = 0; i < 2; ++i) { int R, C; stage_rc(tid * 16 + i * 8192, R, C); const int Rb = Epi::PERM ? ((R & ~31) + perm32(R & 31)) : R;
        voffA[i] = (unsigned)(R * K + C) * 2u; voffB[i] = (unsigned)(Rb * K + C) * 2u; }
    const size_t kstep = (size_t)(BK * 2);
    const size_t hstep = (size_t)HALF * K * 2;
    const size_t tstep = 2 * hstep;
    const unsigned ldsw = (unsigned)wid * 1024u;
    const int aoff = lds_byte(wr * 64 + fr, fq * 8), boff = lds_byte(wc * 32 + fr, fq * 8);
#define PG8_SA(b, h) (((b) * 2 + (h)) * HTB)
#define PG8_SB(b, h) ((4 + (b) * 2 + (h)) * HTB)
#define PG8_STAGE(bufoff, gbase, voff) do { _Pragma("unroll") for (int _i = 0; _i < 2; ++_i) \
        __builtin_amdgcn_global_load_lds((const unsigned*)((const char*)(gbase) + (voff)[_i]), (LAS unsigned*)(lds + (bufoff) + ldsw + _i * 8192), 16, 0, 0); } while (0)
#define PG8_LDA(dst, b, h) do { _Pragma("unroll") for (int m = 0; m < 4; ++m) _Pragma("unroll") for (int k = 0; k < 2; ++k) dst[m][k] = *(const LAS bf16x8*)(lds + PG8_SA(b, h) + aoff + m * 2048 + k * 1024); } while (0)
#define PG8_LDB(dst, b, h) do { _Pragma("unroll") for (int n = 0; n < 2; ++n) _Pragma("unroll") for (int k = 0; k < 2; ++k) dst[n][k] = *(const LAS bf16x8*)(lds + PG8_SB(b, h) + boff + n * 2048 + k * 1024); } while (0)
#define PG8_MMA(ai, bj, At, Bt) do { __builtin_amdgcn_s_setprio(1); _Pragma("unroll") for (int m = 0; m < 4; ++m) _Pragma("unroll") for (int n = 0; n < 2; ++n) _Pragma("unroll") for (int k = 0; k < 2; ++k) \
        acc[ai][bj][m][n] = __builtin_amdgcn_mfma_f32_16x16x32_bf16(Bt[n][k], At[m][k], acc[ai][bj][m][n], 0, 0, 0); __builtin_amdgcn_s_setprio(0); } while (0)
#define PG8_WAIT_V(n) asm volatile("s_waitcnt vmcnt(" #n ")" ::: "memory")
#define PG8_WAIT_L(n) asm volatile("s_waitcnt lgkmcnt(" #n ")" ::: "memory")
#define PG8_BAR __builtin_amdgcn_s_barrier()
#define PG8_SCHED __builtin_amdgcn_sched_barrier(0)
    Unit cur, nxt; int ui = 0;
    if (!S.next(0, cur)) return;
    f32x4 acc[2][2][4][2];
#pragma unroll
    for (int a = 0; a < 2; ++a)
#pragma unroll
        for (int b = 0; b < 2; ++b)
#pragma unroll
            for (int m = 0; m < 4; ++m)
#pragma unroll
                for (int n = 0; n < 2; ++n) acc[a][b][m][n] = (f32x4){0.f, 0.f, 0.f, 0.f};
    bf16x8 At[4][2], B0[2][2], B1[2][2];
    const char* cA = (const char*)g.A + (size_t)cur.pm * tstep; const char* cB = (const char*)g.Bt + (size_t)cur.pn * tstep;
    S.a_ready(cur);
    if constexpr (SP2) {
        PG8_STAGE(PG8_SB(0, 0), cB, voffB); PG8_STAGE(PG8_SB(0, 1), cB + hstep, voffB); PG8_STAGE(PG8_SA(0, 0), cA, voffA); PG8_STAGE(PG8_SA(0, 1), cA + hstep, voffA);
        if (wr == 1) PG8_BAR;
        PG8_WAIT_V(2); PG8_BAR;
        PG8_STAGE(PG8_SB(1, 0), cB + kstep, voffB); PG8_STAGE(PG8_SA(1, 0), cA + kstep, voffA); PG8_STAGE(PG8_SB(1, 1), cB + hstep + kstep, voffB);
        PG8_WAIT_V(6); PG8_BAR;
    } else {
        PG8_STAGE(PG8_SB(0, 0), cB, voffB); PG8_STAGE(PG8_SA(0, 0), cA, voffA); PG8_STAGE(PG8_SB(0, 1), cB + hstep, voffB); PG8_STAGE(PG8_SA(0, 1), cA + hstep, voffA);
        if (wr == 1) PG8_BAR;
        PG8_WAIT_V(4); PG8_BAR;
        PG8_STAGE(PG8_SB(1, 0), cB + kstep, voffB); PG8_STAGE(PG8_SA(1, 0), cA + kstep, voffA); PG8_STAGE(PG8_SB(1, 1), cB + hstep + kstep, voffB);
        PG8_WAIT_V(6); PG8_BAR;
    }
    for (;;) {
        const bool has_next = S.next(ui + 1, nxt);
        const char* nA = has_next ? (const char*)g.A + (size_t)nxt.pm * tstep : cA; const char* nB = has_next ? (const char*)g.Bt + (size_t)nxt.pn * tstep : cB;
        for (int t = 0; t < nt; t += 2) {
            const bool last = (t == nt - 2);
            const char* a1 = cA + (size_t)(t + 1) * kstep;
            const char* a2 = last ? nA : cA + (size_t)(t + 2) * kstep; const char* b2 = last ? nB : cB + (size_t)(t + 2) * kstep;
            const char* a3 = a2 + kstep; const char* b3 = b2 + kstep;
            if (last && has_next) S.a_ready(nxt);
            if constexpr (Epi::MIDK) { if (t == nt / 2) E.mid(acc, cur, wr, wc, fr, fq); }
            if constexpr (SP2) {
            PG8_LDB(B0, 0, 0); PG8_LDB(B1, 0, 1); PG8_SCHED; PG8_LDA(At, 0, 0); PG8_STAGE(PG8_SA(1, 1), a1 + hstep, voffA);
            PG8_WAIT_V(8); PG8_WAIT_L(0); PG8_BAR; PG8_MMA(0, 0, At, B0); PG8_MMA(0, 1, At, B1); PG8_BAR; PG8_SCHED;
            PG8_LDA(At, 0, 1); PG8_STAGE(PG8_SB(0, 0), b2, voffB); PG8_STAGE(PG8_SB(0, 1), b2 + hstep, voffB); PG8_STAGE(PG8_SA(0, 0), a2, voffA);
            PG8_WAIT_V(8); PG8_WAIT_L(0); PG8_BAR; PG8_MMA(1, 0, At, B0); PG8_MMA(1, 1, At, B1); PG8_BAR; PG8_SCHED;
            PG8_LDB(B0, 1, 0); PG8_LDB(B1, 1, 1); PG8_SCHED; PG8_LDA(At, 1, 0); PG8_STAGE(PG8_SA(0, 1), a2 + hstep, voffA);
            PG8_WAIT_V(8); PG8_WAIT_L(0); PG8_BAR; PG8_MMA(0, 0, At, B0); PG8_MMA(0, 1, At, B1); PG8_BAR; PG8_SCHED;
            PG8_LDA(At, 1, 1); PG8_STAGE(PG8_SB(1, 0), b3, voffB); PG8_STAGE(PG8_SB(1, 1), b3 + hstep, voffB); PG8_STAGE(PG8_SA(1, 0), a3, voffA);
            PG8_WAIT_V(8); PG8_WAIT_L(0); PG8_BAR; PG8_MMA(1, 0, At, B0); PG8_MMA(1, 1, At, B1); PG8_BAR; PG8_SCHED;
            } else {
            PG8_LDB(B0, 0, 0); PG8_SCHED; PG8_LDA(At, 0, 0); PG8_STAGE(PG8_SA(1, 1), a1 + hstep, voffA);
            PG8_WAIT_L(8); PG8_BAR; PG8_WAIT_L(0); PG8_MMA(0, 0, At, B0); PG8_BAR; PG8_SCHED;
            PG8_LDB(B1, 0, 1); PG8_STAGE(PG8_SB(0, 0), b2, voffB);
            PG8_BAR; PG8_WAIT_L(0); PG8_MMA(0, 1, At, B1); PG8_BAR;
            PG8_LDA(At, 0, 1); PG8_STAGE(PG8_SA(0, 0), a2, voffA);
            PG8_BAR; PG8_WAIT_L(0); PG8_MMA(1, 0, At, B0); PG8_BAR; PG8_SCHED;
            PG8_STAGE(PG8_SB(0, 1), b2 + hstep, voffB);
            PG8_WAIT_V(6); PG8_BAR; PG8_MMA(1, 1, At, B1); PG8_BAR;
            PG8_LDB(B0, 1, 0); PG8_SCHED; PG8_LDA(At, 1, 0); PG8_STAGE(PG8_SA(0, 1), a2 + hstep, voffA);
            PG8_WAIT_L(8); PG8_BAR; PG8_WAIT_L(0); PG8_MMA(0, 0, At, B0); PG8_BAR; PG8_SCHED;
            PG8_LDB(B1, 1, 1); PG8_STAGE(PG8_SB(1, 0), b3, voffB);
            PG8_BAR; PG8_WAIT_L(0); PG8_MMA(0, 1, At, B1); PG8_BAR;
            PG8_LDA(At, 1, 1); PG8_STAGE(PG8_SA(1, 0), a3, voffA);
            PG8_BAR; PG8_WAIT_L(0); PG8_MMA(1, 0, At, B0); PG8_BAR; PG8_SCHED;
            PG8_STAGE(PG8_SB(1, 1), b3 + hstep, voffB);
            PG8_WAIT_V(6); PG8_BAR; PG8_MMA(1, 1, At, B1); PG8_BAR;
            }
        }
        if constexpr (ALIGN_EPI) { if (wr == 0) PG8_BAR; }
        E(acc, cur, wr, wc, fr, fq); S.done(cur);
        if (!has_next) break;
#pragma unroll
        for (int a = 0; a < 2; ++a)
#pragma unroll
            for (int b = 0; b < 2; ++b)
#pragma unroll
                for (int m = 0; m < 4; ++m)
#pragma unroll
                    for (int n = 0; n < 2; ++n) acc[a][b][m][n] = (f32x4){0.f, 0.f, 0.f, 0.f};
        cur = nxt; cA = nA; cB = nB; ++ui;
        if constexpr (ALIGN_EPI) { if (wr == 1) PG8_BAR; }
    }
    PG8_WAIT_V(0);
    if constexpr (!ALIGN_EPI) { if (wr == 0) PG8_BAR; }
    PG8_BAR;
#undef PG8_SA
#undef PG8_SB
#undef PG8_STAGE
#undef PG8_LDA
#undef PG8_LDB
#undef PG8_MMA
#undef PG8_WAIT_V
#undef PG8_WAIT_L
#undef PG8_BAR
#undef PG8_SCHED
}
}

template <int MODE>
__device__ __forceinline__ void mini_gemm(LAS unsigned char* lds, const bf16* A, const bf16* Bt, int unit, int wave, int lane, int tid, const bf16* msig_s, bf16* mrg_s, const float* xs, float* ys) {
    const int r0 = (unit >> 6) * 64, c0 = (unit & 63) * 32;
    const int m = lane & 15, kq = lane >> 4;
    const bf16* ap = A + (size_t)(r0 + m) * 2048 + wave * 256 + 8 * kq;
    const bf16* bp = Bt + (size_t)(c0 + m) * 2048 + wave * 256 + 8 * kq;
    f32x4 acc[4][2];
#pragma unroll
    for (int i = 0; i < 4; ++i) { acc[i][0] = (f32x4){0.f, 0.f, 0.f, 0.f}; acc[i][1] = acc[i][0]; }
    bf16x8 fa[4][4], fb[4][2];
    const bf16* ap1 = ap + 16 * 2048; const bf16* ap2 = ap + 32 * 2048; const bf16* ap3 = ap + 48 * 2048; const bf16* bp1 = bp + 16 * 2048;
#define MG_LD(dst_, ptr_, st_) asm volatile("global_load_dwordx4 %0, %1, off offset:%2" : "=&v"(dst_) : "v"(ptr_), "n"(64 * (st_)) : "memory")
#define MG_LOAD(st_) do { MG_LD(fa[(st_) & 3][0], ap, st_); MG_LD(fa[(st_) & 3][1], ap1, st_); MG_LD(fa[(st_) & 3][2], ap2, st_); MG_LD(fa[(st_) & 3][3], ap3, st_); \
                          MG_LD(fb[(st_) & 3][0], bp, st_); MG_LD(fb[(st_) & 3][1], bp1, st_); } while (0)
    const int rl = tid >> 3, cl = (tid & 7) * 4, row = r0 + rl, col = c0 + cl;
    u32x2 gs, gf; f32x4 xin;
    if (MODE == 0) { gs = *(const u32x2*)(msig_s + (size_t)row * 4096 + col); gf = *(const u32x2*)(msig_s + (size_t)row * 4096 + 2048 + col); }
    else xin = *(const f32x4*)(xs + (size_t)row * 2048 + col);
    __builtin_amdgcn_sched_barrier(0);
    MG_LOAD(0); MG_LOAD(1); MG_LOAD(2); MG_LOAD(3);
#pragma unroll
    for (int st = 0; st < 8; ++st) {
        __builtin_amdgcn_sched_barrier(0);
        if (st <= 4) asm volatile("s_waitcnt vmcnt(18)" ::: "memory"); else if (st == 5) asm volatile("s_waitcnt vmcnt(12)" ::: "memory");
        else if (st == 6) asm volatile("s_waitcnt vmcnt(6)" ::: "memory"); else asm volatile("s_waitcnt vmcnt(0)" ::: "memory");
        __builtin_amdgcn_sched_barrier(0);
#pragma unroll
        for (int i = 0; i < 4; ++i)
#pragma unroll
            for (int j = 0; j < 2; ++j) acc[i][j] = __builtin_amdgcn_mfma_f32_16x16x32_bf16(fb[st & 3][j], fa[st & 3][i], acc[i][j], 0, 0, 0);
        __builtin_amdgcn_sched_barrier(0);
        if (st + 4 < 8) MG_LOAD(st + 4);
    }
#undef MG_LOAD
#undef MG_LD
    LAS float* part = (LAS float*)lds + wave * 2048;
#pragma unroll
    for (int i = 0; i < 4; ++i)
#pragma unroll
        for (int j = 0; j < 2; ++j) *(LAS f32x4*)(part + (16 * i + m) * 32 + 16 * j + 4 * kq) = acc[i][j];
    LDS_WAIT(); __syncthreads();
    {
        const LAS float* pp = (const LAS float*)lds + rl * 32 + cl;
        f32x4 s1 = *(const LAS f32x4*)pp + *(const LAS f32x4*)(pp + 2048) + *(const LAS f32x4*)(pp + 4096) + *(const LAS f32x4*)(pp + 6144);
        f32x4 s2 = *(const LAS f32x4*)(pp + 8192) + *(const LAS f32x4*)(pp + 10240) + *(const LAS f32x4*)(pp + 12288) + *(const LAS f32x4*)(pp + 14336);
        if (MODE == 0) {
            u32x2 w; w.x = cvt_pk_bf16(s1[0] * bf_lo(gs.x) + s2[0] * bf_lo(gf.x), s1[1] * bf_hi(gs.x) + s2[1] * bf_hi(gf.x));
            w.y = cvt_pk_bf16(s1[2] * bf_lo(gs.y) + s2[2] * bf_lo(gf.y), s1[3] * bf_hi(gs.y) + s2[3] * bf_hi(gf.y));
            *(u32x2*)(mrg_s + (size_t)row * 2048 + col) = w;
        } else {
            *(f32x4*)(ys + (size_t)row * 2048 + col) = s1 + s2 + xin;
        }
    }
    LDS_WAIT(); __syncthreads();
}

#define XB_TMO      128
#define XB_XCNT(j)  (256  + 64 * (j))
#define XB_XSUB(j)  (1280 + 64 * (j))
#define XB_XGEN(j)  (2304 + 64 * (j))
#define XB_TOP      3328
#define XB_TOPGEN   3392
#define XCD_BAR_WORDS 3456
#define XB_SPIN_CAP (1u << 18)
__device__ __forceinline__ unsigned xb_ld(unsigned* p)              { return __hip_atomic_load(p, __ATOMIC_RELAXED, __HIP_MEMORY_SCOPE_AGENT); }
__device__ __forceinline__ unsigned xb_add(unsigned* p, unsigned v) { return __hip_atomic_fetch_add(p, v, __ATOMIC_RELAXED, __HIP_MEMORY_SCOPE_AGENT); }
__device__ __forceinline__ unsigned xb_xcc_id() { return (unsigned)__builtin_amdgcn_s_getreg((3 << 11) | 20) & 0xFu; }
#define XB_SPIN(cond, bar) do { unsigned _sp = 0; while (cond) { __builtin_amdgcn_s_sleep(1); \
    if ((++_sp & 255u) == 0u) { if (xb_ld(&(bar)[XB_TMO])) break; if (_sp > XB_SPIN_CAP) { atomicAdd(&(bar)[XB_TMO], 1u); break; } } } } while (0)
struct XcdBarrier { unsigned* bar; unsigned x; volatile LAS unsigned* st; int wave; };
__device__ __forceinline__ XcdBarrier xcd_barrier_post(unsigned* bar, volatile LAS unsigned* st, int wave) {
    XcdBarrier b; b.bar = bar; b.x = xb_xcc_id(); b.st = st; b.wave = wave;
    if (wave == 0 && lane_id() == 0) (void)xb_add(&bar[XB_XCNT(b.x)], 1u);
    return b;
}
__device__ __forceinline__ void xcd_barrier_complete(unsigned* bar, unsigned x, unsigned& nloc, unsigned& nx) {
    const unsigned G = gridDim.x * gridDim.y * gridDim.z;
    unsigned sum, cnt, mine, sp = 0u;
    for (;;) {
        sum = 0u; cnt = 0u; mine = 0u;
#pragma unroll
        for (unsigned j = 0; j < 16; ++j) { const unsigned c = xb_ld(&bar[XB_XCNT(j)]); sum += c; cnt += (c > 0u) ? 1u : 0u; mine = (j == x) ? c : mine; }
        if (sum == G) break;
        __builtin_amdgcn_s_sleep(1);
        if ((++sp & 255u) == 0u) { if (xb_ld(&bar[XB_TMO])) break; if (sp > XB_SPIN_CAP) { atomicAdd(&bar[XB_TMO], 1u); break; } }
    }
    nloc = mine > 0u ? mine : 1u; nx = cnt > 0u ? cnt : 1u;
}
__device__ __forceinline__ void xcd_barrier(const XcdBarrier& b) {
    asm volatile("s_waitcnt vmcnt(0)" ::: "memory");
    __syncthreads();
    if (b.wave == 0 && lane_id() == 0) {
        unsigned* bar = b.bar;
        __builtin_amdgcn_s_waitcnt(0);
        unsigned nloc = b.st[0], nx = b.st[1];
        if (nloc == 0u) { xcd_barrier_complete(bar, b.x, nloc, nx); b.st[0] = nloc; b.st[1] = nx; }
        const unsigned old = xb_add(&bar[XB_XSUB(b.x)], 1u);
        const unsigned gen = old / nloc;
        if (old + 1u == (gen + 1u) * nloc) {
            __builtin_amdgcn_fence(__ATOMIC_RELEASE, "agent");
            asm volatile("s_waitcnt vmcnt(0)" ::: "memory");
            const unsigned og = xb_add(&bar[XB_TOP], 1u);
            const unsigned tg = og / nx;
            if (og + 1u == (tg + 1u) * nx) xb_add(&bar[XB_TOPGEN], 1u);
            else XB_SPIN(xb_ld(&bar[XB_TOPGEN]) == tg, bar);
            __builtin_amdgcn_fence(__ATOMIC_ACQUIRE, "agent");
            xb_add(&bar[XB_XGEN(b.x)], 1u);
            asm volatile("s_waitcnt vmcnt(0)" ::: "memory");
        } else {
            XB_SPIN(xb_ld(&bar[XB_XGEN(b.x)]) == gen, bar);
            __builtin_amdgcn_fence(__ATOMIC_ACQUIRE, "agent");
            asm volatile("s_waitcnt vmcnt(0)" ::: "memory");
        }
    }
    __syncthreads();
}

__device__ __forceinline__ float wave_sum(float v) {
#pragma unroll
    for (int o = 1; o < 64; o <<= 1) v += __shfl_xor(v, o);
    return v;
}
__device__ __forceinline__ void p0_transpose_item(const float* W, int ld, int nblk, bf16* WT, int ldt, LAS float* scr, int item, int lane) {
    const int kb = item / nblk, nb = item % nblk, k0 = 64 * kb, n0 = 32 * nb;
#pragma unroll 8
    for (int i = 0; i < 32; ++i) { const int kk = 2 * i + (lane >> 5); scr[kk * 33 + (lane & 31)] = __builtin_nontemporal_load(W + (size_t)(k0 + kk) * ld + n0 + (lane & 31)); }
    LDS_WAIT(); asm volatile("" ::: "memory");
    const int c = lane & 7;
#pragma unroll
    for (int j = 0; j < 4; ++j) { const int n = (lane >> 3) + 8 * j; const LAS float* s = scr + (8 * c) * 33 + n;
        u32x4 o; o.x = cvt_pk_bf16(s[0 * 33], s[1 * 33]); o.y = cvt_pk_bf16(s[2 * 33], s[3 * 33]); o.z = cvt_pk_bf16(s[4 * 33], s[5 * 33]); o.w = cvt_pk_bf16(s[6 * 33], s[7 * 33]);
        *(u32x4*)(WT + (size_t)(n0 + n) * ldt + k0 + 8 * c) = o; }
    LDS_WAIT(); asm volatile("" ::: "memory");
}

struct Ptrs {
    const float *xp, *xs, *csbk, *csbv, *cfxk, *cfxv, *cflf, *normw, *win, *bfor, *qnw, *knw, *wbsb, *wbfx, *wout;
    float* out; unsigned char* ws;
};

__device__ __forceinline__ void p0_prologue(const Ptrs& P, LAS unsigned char* lds, int gw, int NGW, int wave, int lane, int tid) {
    LAS float* wfT = (LAS float*)(lds + 69632);
    for (int i = tid; i < 2048 * 2; i += 512) { const int k = i >> 1, hf = i & 1; const f32x4 v = *(const f32x4*)(P.win + (size_t)k * DIN + 8192 + 4 * hf);
#pragma unroll
        for (int j = 0; j < 4; ++j) wfT[(4 * hf + j) * 2048 + k] = v[j]; }
    LAS float* scr = (LAS float*)(lds + wave * 8448);
    constexpr int I_A = 32 * 256, I_B = 32 * 128, NITEMS = I_A + I_B;
    bf16* Wt = (bf16*)(P.ws + WS_WIN);
    for (int it = gw; it < NITEMS; it += NGW) {
        int r = it;
        if (r < I_A) { p0_transpose_item(P.win, DIN, 256, Wt, 2048, scr, r, lane); continue; } r -= I_A;
        p0_transpose_item(P.win + 8200, DIN, 128, Wt + (size_t)8192 * 2048, 2048, scr, r, lane);
    }
    __syncthreads();
    f32x4 nw[8];
#pragma unroll
    for (int i = 0; i < 8; ++i) nw[i] = *(const f32x4*)(P.normw + 4 * lane + 256 * i);
    bf16* H = (bf16*)(P.ws + WS_H);
    for (int m = gw; m < TT; m += NGW) {
        const float* xr = (m < TP) ? P.xp + (size_t)m * DM : P.xs + (size_t)(m - TP) * DM;
        f32x4 v[8]; float ss = 0.f;
#pragma unroll
        for (int i = 0; i < 8; ++i) { v[i] = *(const f32x4*)(xr + 4 * lane + 256 * i); ss += (v[i][0] * v[i][0] + v[i][1] * v[i][1]) + (v[i][2] * v[i][2] + v[i][3] * v[i][3]); }
        const float rstd = 1.0f / sqrtf(wave_sum(ss) * (1.0f / DM) + RMS_EPS);
        unsigned long long* o8 = (unsigned long long*)(H + (size_t)m * DM) + lane;
        float fl[8] = {0.f, 0.f, 0.f, 0.f, 0.f, 0.f, 0.f, 0.f};
#pragma unroll
        for (int i = 0; i < 8; ++i) { v[i] = v[i] * rstd * nw[i];
            o8[64 * i] = (unsigned long long)cvt_pk_bf16(v[i][0], v[i][1]) | ((unsigned long long)cvt_pk_bf16(v[i][2], v[i][3]) << 32);
#pragma unroll
            for (int j = 0; j < 8; ++j) { const f32x4 w = *(const LAS f32x4*)(wfT + j * 2048 + 4 * lane + 256 * i); fl[j] += (v[i][0] * w[0] + v[i][1] * w[1]) + (v[i][2] * w[2] + v[i][3] * w[3]); } }
        float mine = 0.f;
#pragma unroll
        for (int j = 0; j < 8; ++j) { const float t = wave_sum(fl[j]); mine = (lane == j) ? t : mine; }
        if (lane < 8) { const float z = mine + P.bfor[lane]; const float lf = fminf(z, 0.f) - log1pf(expf(-fabsf(z)));
            float* dst = (m < TP) ? P.out + O_PLF + (size_t)m * 8 : P.out + O_SLF + (size_t)(m - TP) * 8; dst[lane] = lf; }
    }
}

__device__ __forceinline__ void p1_side_weights(const Ptrs& P, LAS unsigned char* lds, int sw, int nsw, int wave, int lane) {
    LAS float* scr = (LAS float*)(lds + wave * 8448);
    constexpr int I_S = 16 * 64, I_O = 32 * 64, NITEMS = 2 * I_S + I_O;
    bf16* Wb = (bf16*)(P.ws + WS_WB); bf16* Wo = (bf16*)(P.ws + WS_WO);
    for (int it = sw; it < NITEMS; it += nsw) {
        int r = it;
        if (r < I_S) { p0_transpose_item(P.wbsb, 2048, 64, Wb, 2048, scr, r, lane); continue; } r -= I_S;
        if (r < I_S) { p0_transpose_item(P.wbfx, 2048, 64, Wb + 1024, 2048, scr, r, lane); continue; } r -= I_S;
        p0_transpose_item(P.wout, 2048, 64, Wo, 2048, scr, r, lane);
    }
}

__device__ __forceinline__ void p1_side_knorm(const Ptrs& P, int sw, int nsw, int lane) {
    const int r32 = lane & 31, hi = lane >> 5;
    float* kmx = (float*)(P.ws + WS_KMX);
    for (int it = sw; it < NBAT * NH * KN_TILES; it += nsw) {
        const int h = it & 7, bt = it >> 3, b = bt / KN_TILES, tix = bt - b * KN_TILES, bh = b * 8 + h;
        const float* src = P.cfxk + ((size_t)(b * PAST + tix * 32 + hi) * NH + h) * HD + r32 * 4;
        float mx = 0.f;
#pragma unroll 1
        for (int half = 0; half < 2; ++half) {
            f32x4 t[8];
#pragma unroll
            for (int i = 0; i < 8; ++i) t[i] = __builtin_nontemporal_load((const f32x4*)(src + (size_t)(half * 8 + i) * 2 * NH * HD));
#pragma unroll
            for (int i = 0; i < 8; ++i) { float s_ = t[i][0] * t[i][0] + t[i][1] * t[i][1] + t[i][2] * t[i][2] + t[i][3] * t[i][3];
#pragma unroll
                for (int o = 1; o < 32; o <<= 1) s_ += __shfl_xor(s_, o);
                mx = fmaxf(mx, s_); }
        }
        mx = fmaxf(mx, __shfl_xor(mx, 32));
        if (lane == 0) kmx[bh * 128 + tix] = mx;
    }
}

__device__ __forceinline__ void scan_seq(const Ptrs& P, LAS unsigned char* lds, int id, int tid) {
    LAS float* sm = (LAS float*)(lds + XCH_OFF);
    const float* s1; int n1, st1; const float* s2; int n2; float* dst;
    if (id < 8) { s1 = P.out + O_PLF + id; n1 = TP; st1 = 8; s2 = s1; n2 = 0; dst = (float*)(P.ws + WS_F2P) + (size_t)id * TP; }
    else { const int b = (id - 8) >> 3, j = (id - 8) & 7; s1 = P.cflf + (size_t)b * PAST * 8 + j; n1 = PAST; st1 = 8; s2 = P.out + O_SLF + (size_t)b * NSEQ * 8 + j; n2 = NSEQ;
        dst = (float*)(P.ws + WS_F2S) + (size_t)(b * 8 + j) * KT; }
    const int n = n1 + n2, CH = (n + 511) / 512;
    float v[16]; float run = 0.f;
#pragma unroll
    for (int i = 0; i < 16; ++i) { const int idx = tid * CH + i; if (i < CH && idx < n) { const float x = idx < n1 ? s1[(size_t)idx * st1] : s2[(size_t)(idx - n1) * 8]; run += x; } v[i] = run; }
    const int lane = tid & 63, wave = tid >> 6;
    float inc = run;
#pragma unroll
    for (int o = 1; o < 64; o <<= 1) { const float t = __shfl_up(inc, o); if (lane >= o) inc += t; }
    if (lane == 63) sm[wave] = inc;
    LDS_WAIT(); __syncthreads();
    float base = inc - run;
    for (int w = 0; w < wave; ++w) base += sm[w];
#pragma unroll
    for (int i = 0; i < 16; ++i) { const int idx = tid * CH + i; if (i < CH && idx < n) dst[idx] = (base + v[i]) * LOG2E; }
    __syncthreads();
}

namespace att {
constexpr int SHM_T = 16384;
#define KSWZ(row, colB) ((row) * 256 + ((colB) ^ (((row) & 7) << 4)))
__device__ __forceinline__ int v_st(int k, int c) { const int kk = (k & ~0xC) | ((k & 4) << 1) | ((k & 8) >> 1); return ((kk >> 3) * 4 + (c >> 5)) * 512 + ((kk & 7) * 32 + (c & 31)) * 2; }
__device__ __forceinline__ int v_rd_base(int lane) { return ((lane & 3) << 3) | (((lane >> 2) & 3) << 6) | (((lane >> 4) & 1) << 5) | (((lane >> 5) & 1) << 8); }
__device__ __forceinline__ int crow(int r, int hi) { return (r & 3) + 8 * (r >> 2) + 4 * hi; }

__device__ __forceinline__ __amdgpu_buffer_rsrc_t mk_rsrc(const void* p, int bytes) {
    const unsigned long long a = (unsigned long long)p;
    const unsigned lo = __builtin_amdgcn_readfirstlane((unsigned)a), hi = __builtin_amdgcn_readfirstlane((unsigned)(a >> 32));
    return __builtin_amdgcn_make_buffer_rsrc((void*)(((unsigned long long)hi << 32) | lo), 0, bytes, 0x00020000);
}
template <int NB>
__device__ __forceinline__ void qkt(f32x16& p0, f32x16& p1, const LAS char* Kb, int r32, int hi, const bf16x8 (&qr)[8]) {
    p0 = (f32x16){0.f, 0.f, 0.f, 0.f, 0.f, 0.f, 0.f, 0.f, 0.f, 0.f, 0.f, 0.f, 0.f, 0.f, 0.f, 0.f}; p1 = p0;
    const LAS char* kb[4];
#pragma unroll
    for (int dd = 0; dd < 4; ++dd) kb[dd] = Kb + KSWZ(r32, (dd * 16 + hi * 8) * 2);
#pragma unroll
    for (int d0 = 0; d0 < 8; ++d0) { const LAS char* a = kb[d0 & 3] + (d0 >> 2) * 128;
        const bf16x8 b0 = *(const LAS bf16x8*)a;
        p0 = __builtin_amdgcn_mfma_f32_32x32x16_bf16(b0, qr[d0], p0, 0, 0, 0);
        if (NB == 2) { const bf16x8 b1 = *(const LAS bf16x8*)(a + 32 * 256); p1 = __builtin_amdgcn_mfma_f32_32x32x16_bf16(b1, qr[d0], p1, 0, 0, 0); } }
}
__device__ __forceinline__ void qkt_qlds(f32x16& p0, const LAS char* Kb, const LAS char* Qb, int r32, int hi, int qrow) {
    p0 = (f32x16){0.f, 0.f, 0.f, 0.f, 0.f, 0.f, 0.f, 0.f, 0.f, 0.f, 0.f, 0.f, 0.f, 0.f, 0.f, 0.f};
    const LAS char* kb[4];
#pragma unroll
    for (int dd = 0; dd < 4; ++dd) kb[dd] = Kb + KSWZ(r32, (dd * 16 + hi * 8) * 2);
    const LAS char* qb = Qb + qrow * 256;
#pragma unroll
    for (int d0 = 0; d0 < 8; ++d0) { const LAS char* a = kb[d0 & 3] + (d0 >> 2) * 128;
        const bf16x8 b0 = *(const LAS bf16x8*)a;
        const bf16x8 q = *(const LAS bf16x8*)(qb + (((d0 * 2 + hi) ^ qrow) << 4));
        p0 = __builtin_amdgcn_mfma_f32_32x32x16_bf16(b0, q, p0, 0, 0, 0); }
}
template <int NB>
__device__ __forceinline__ void pv_tile(f32x16 (&o)[4], int vb0, bf16x8 pa0, bf16x8 pa1, bf16x8 pa2, bf16x8 pa3) {
#define TRRD(dst, off) asm volatile("ds_read_b64_tr_b16 %0, %1 offset:%2" : "=&v"(dst) : "v"(vb0), "i"(off) : "memory")
#define PV_D0(d0) do { s16x4 l0, l1, l2, l3, h0, h1, h2, h3; constexpr int b_ = (d0) * 512;   \
        TRRD(l0, b_); TRRD(h0, b_ + 2048); TRRD(l1, b_ + 4096); TRRD(h1, b_ + 6144);   \
        if (NB == 2) { TRRD(l2, b_ + 8192); TRRD(h2, b_ + 10240); TRRD(l3, b_ + 12288); TRRD(h3, b_ + 14336); }   \
        asm volatile("s_waitcnt lgkmcnt(0)" ::: "memory"); __builtin_amdgcn_sched_barrier(0);   \
        o[d0] = __builtin_amdgcn_mfma_f32_32x32x16_bf16(pa0, (bf16x8){l0[0], l0[1], l0[2], l0[3], h0[0], h0[1], h0[2], h0[3]}, o[d0], 0, 0, 0);   \
        o[d0] = __builtin_amdgcn_mfma_f32_32x32x16_bf16(pa1, (bf16x8){l1[0], l1[1], l1[2], l1[3], h1[0], h1[1], h1[2], h1[3]}, o[d0], 0, 0, 0);   \
        if (NB == 2) {   \
        o[d0] = __builtin_amdgcn_mfma_f32_32x32x16_bf16(pa2, (bf16x8){l2[0], l2[1], l2[2], l2[3], h2[0], h2[1], h2[2], h2[3]}, o[d0], 0, 0, 0);   \
        o[d0] = __builtin_amdgcn_mfma_f32_32x32x16_bf16(pa3, (bf16x8){l3[0], l3[1], l3[2], l3[3], h3[0], h3[1], h3[2], h3[3]}, o[d0], 0, 0, 0); } } while (0)
    PV_D0(0); PV_D0(1); PV_D0(2); PV_D0(3);
#undef PV_D0
#undef TRRD
}
#define PK4(P, B_, OUT) do { unsigned a0 = cvt_pk_bf16(P[B_+0], P[B_+1]), a1 = cvt_pk_bf16(P[B_+2], P[B_+3]);   \
        unsigned b0 = cvt_pk_bf16(P[B_+4], P[B_+5]), b1 = cvt_pk_bf16(P[B_+6], P[B_+7]);   \
        auto r0 = __builtin_amdgcn_permlane32_swap(a0, b0, false, false); auto r1 = __builtin_amdgcn_permlane32_swap(a1, b1, false, false);   \
        u32x4 w = {r0[0], r1[0], r0[1], r1[1]}; OUT = __builtin_bit_cast(bf16x8, w); } while (0)

__device__ __forceinline__ void xchg32(float v, float& x0, float& x1) {
    const unsigned a = __builtin_bit_cast(unsigned, v);
    auto rr = __builtin_amdgcn_permlane32_swap(a, a, false, false);
    const unsigned r0 = rr[0], r1 = rr[1];
    x0 = __builtin_bit_cast(float, r0); x1 = __builtin_bit_cast(float, r1);
}
template <int NB, bool MASK>
__device__ __forceinline__ float sb_step_a(f32x16& p0, f32x16& p1, int dq, int hi, float (&PS)[8], float (&GS)[8]) {
#pragma unroll
    for (int r = 0; r < 16; ++r) {
        const int c = (r & 3) + 8 * (r >> 2);
        float a = __builtin_amdgcn_rcpf(1.0f + __builtin_amdgcn_exp2f(p0[r])); if (MASK) a = (c < dq) ? a : 1.0f; p0[r] = a;
        if (NB == 2) { float b = __builtin_amdgcn_rcpf(1.0f + __builtin_amdgcn_exp2f(p1[r])); if (MASK) b = (c + 32 < dq) ? b : 1.0f; p1[r] = b; }
    }
    float tot = 1.0f;
#pragma unroll
    for (int g = 0; g < 4 * NB; ++g) {
        const int r = 4 * (g & 3);
        const float G = (g < 4) ? (p0[r] * p0[r + 1]) * (p0[r + 2] * p0[r + 3]) : (p1[r] * p1[r + 1]) * (p1[r + 2] * p1[r + 3]);
        float x0, x1; xchg32(G, x0, x1);
        PS[g] = x0 * x1; GS[g] = hi ? 1.0f : x1; tot *= PS[g];
    }
    return tot;
}
template <int NB>
__device__ __forceinline__ void sb_step_b(f32x16& p0, f32x16& p1, float C, const float (&PS)[8], const float (&GS)[8], bf16x8& pa0, bf16x8& pa1, bf16x8& pa2, bf16x8& pa3) {
    float X = C;
#pragma unroll
    for (int g = 4 * NB - 1; g >= 0; --g) {
        const int r = 4 * (g & 3);
        const float E = X * GS[g];
        if (g < 4) { const float a0 = p0[r], a1 = p0[r + 1], a2 = p0[r + 2], a3 = p0[r + 3]; const float P3 = E, P2 = P3 * a3, P1 = P2 * a2, P0 = P1 * a1;
            p0[r + 3] = __builtin_fmaf(-P3, a3, P3); p0[r + 2] = __builtin_fmaf(-P2, a2, P2); p0[r + 1] = __builtin_fmaf(-P1, a1, P1); p0[r] = __builtin_fmaf(-P0, a0, P0); }
        else { const float a0 = p1[r], a1 = p1[r + 1], a2 = p1[r + 2], a3 = p1[r + 3]; const float P3 = E, P2 = P3 * a3, P1 = P2 * a2, P0 = P1 * a1;
            p1[r + 3] = __builtin_fmaf(-P3, a3, P3); p1[r + 2] = __builtin_fmaf(-P2, a2, P2); p1[r + 1] = __builtin_fmaf(-P1, a1, P1); p1[r] = __builtin_fmaf(-P0, a0, P0); }
        X *= PS[g];
    }
    PK4(p0, 0, pa0); PK4(p0, 8, pa1);
    if (NB == 2) { PK4(p1, 0, pa2); PK4(p1, 8, pa3); }
}
template <int NB, bool MASK, class FPtr>
__device__ __forceinline__ float fox_weights(f32x16& p0, f32x16& p1, FPtr F2k, int dq, float& m, float& l, float& alpha, bf16x8& pa0, bf16x8& pa1, bf16x8& pa2, bf16x8& pa3) {
    const float NEG = -__builtin_inff();
    float mx = NEG;
#pragma unroll
    for (int g = 0; g < 4; ++g) {
        const f32x4 f0 = F2k[2 * g];
#pragma unroll
        for (int i = 0; i < 4; ++i) { float x = p0[4 * g + i] - f0[i]; if (MASK) x = (i + 8 * g <= dq) ? x : NEG; p0[4 * g + i] = x; mx = fmaxf(mx, x); }
        if (NB == 2) { const f32x4 f1 = F2k[8 + 2 * g];
#pragma unroll
            for (int i = 0; i < 4; ++i) { float x = p1[4 * g + i] - f1[i]; if (MASK) x = (i + 8 * g + 32 <= dq) ? x : NEG; p1[4 * g + i] = x; mx = fmaxf(mx, x); } }
    }
    { float x0, x1; xchg32(mx, x0, x1); mx = fmaxf(x0, x1); }
    const float mn = fmaxf(m, mx);
    alpha = __builtin_amdgcn_exp2f(m - mn); m = mn;
    float ps = 0.f;
#pragma unroll
    for (int r = 0; r < 16; ++r) { p0[r] = __builtin_amdgcn_exp2f(p0[r] - mn); ps += p0[r]; if (NB == 2) { p1[r] = __builtin_amdgcn_exp2f(p1[r] - mn); ps += p1[r]; } }
    { float x0, x1; xchg32(ps, x0, x1); ps = x0 + x1; }
    l = l * alpha + ps;
    PK4(p0, 0, pa0); PK4(p0, 8, pa1);
    if (NB == 2) { PK4(p1, 0, pa2); PK4(p1, 8, pa3); }
    return ps;
}

__device__ __forceinline__ void qk_half(f32x16& p, const LAS char* Kb, int r32, int hi, const LAS char* qx, int rx) {
    p = (f32x16){0.f, 0.f, 0.f, 0.f, 0.f, 0.f, 0.f, 0.f, 0.f, 0.f, 0.f, 0.f, 0.f, 0.f, 0.f, 0.f};
    const LAS char* kb[4];
#pragma unroll
    for (int dd = 0; dd < 4; ++dd) kb[dd] = Kb + KSWZ(r32, (dd * 16 + hi * 8) * 2);
#pragma unroll
    for (int d0 = 0; d0 < 8; ++d0) { const bf16x8 b0 = *(const LAS bf16x8*)(kb[d0 & 3] + (d0 >> 2) * 128);
        const bf16x8 q = *(const LAS bf16x8*)(qx + (((d0 * 2 + hi) ^ rx) << 4));
        p = __builtin_amdgcn_mfma_f32_32x32x16_bf16(b0, q, p, 0, 0, 0);
        if (d0 < 7) __builtin_amdgcn_sched_barrier(0x0011); }
}
template <bool UP>
__device__ __forceinline__ void pv_half(f32x16 (&o)[4], int vb0, bf16x8 pa0, bf16x8 pa1) {
#define TRRD(dst, off) asm volatile("ds_read_b64_tr_b16 %0, %1 offset:%2" : "=&v"(dst) : "v"(vb0), "i"(off) : "memory")
#define PV_D0(d0) do { s16x4 l0, l1, h0, h1; constexpr int b_ = (d0) * 512 + (UP ? 8192 : 0);   \
        TRRD(l0, b_); TRRD(h0, b_ + 2048); TRRD(l1, b_ + 4096); TRRD(h1, b_ + 6144);   \
        asm volatile("s_waitcnt lgkmcnt(0)" ::: "memory"); __builtin_amdgcn_sched_barrier(0);   \
        o[d0] = __builtin_amdgcn_mfma_f32_32x32x16_bf16(pa0, (bf16x8){l0[0], l0[1], l0[2], l0[3], h0[0], h0[1], h0[2], h0[3]}, o[d0], 0, 0, 0);   \
        o[d0] = __builtin_amdgcn_mfma_f32_32x32x16_bf16(pa1, (bf16x8){l1[0], l1[1], l1[2], l1[3], h1[0], h1[1], h1[2], h1[3]}, o[d0], 0, 0, 0); } while (0)
    PV_D0(0); PV_D0(1); PV_D0(2); PV_D0(3);
#undef PV_D0
#undef TRRD
}

template <int MODE>
__device__ __forceinline__ void prompt_block(LAS char* lds, const bf16* Qh, const bf16* Kh, const bf16* Vh, const float* F2h, const bf16* Gh, bf16* Ah, int qb, float zb, int wave_) {
    int tid_ = wave_ * 64 + lane_id(); asm volatile("" : "+v"(tid_));
    const int tid = tid_, wid = __builtin_amdgcn_readfirstlane(tid >> 6), lane = tid & 63, r32 = lane & 31, hi = lane >> 5;
    const int P0 = qb * 256, qlo = P0 + wid * 32, trow = qlo + r32;
    LAS char* Vl = lds; LAS char* Kl = lds + 2 * SHM_T;
    LAS float* wsm = (LAS float*)(lds + 5 * SHM_T) + wid * 64; LAS int* flg = (LAS int*)(lds + 5 * SHM_T + 2048);
    LAS float* fbuf = (LAS float*)(lds + 5 * SHM_T + 4096);
    LAS char* Qw = lds + 5 * SHM_T + 8192 + wid * 8192;
#pragma unroll
    for (int i = 0; i < 8; ++i) { const int idx = lane + 64 * i, r = idx >> 4, c = idx & 15;
        *(LAS bf16x8*)(Qw + r * 256 + ((c ^ (r & 15)) << 4)) = *(const bf16x8*)(Qh + (size_t)(qlo + r) * 128 + c * 8); }
    const LAS char* qx = Qw + r32 * 256; const int rx = r32 & 15;
    const int NT = 4 * qb + 4;
    const int sr = tid >> 4, sc = (tid & 15) * 8;
    const int kws = KSWZ(sr, sc * 2), vst0 = v_st(sr, sc), vst1 = v_st(32 + sr, sc);
    const int vrb = (int)(unsigned)(size_t)Vl + v_rd_base(lane);
    bf16x8 sk0, sk1, sv0, sv1; float sf = 0.f;
#define PB_KB(it_) ((NT - 1 - (it_)) * 64)
#define PB_ACT(hk_) ((MODE == 0) ? ((hk_) <= qlo + 30) : ((hk_) <= qlo + 31))
#define PB_NM(hk_) ((MODE == 0) ? ((hk_) + 31 >= qlo) : ((hk_) + 31 > qlo))
    const __amdgpu_buffer_rsrc_t rK = mk_rsrc(Kh, TT * 256), rV = mk_rsrc(Vh, TT * 256);
    const int svo = sr * 256 + sc * 2;
#define PB_LOADK(it_) do { const int so_ = PB_KB(it_) * 256; sk0 = __builtin_bit_cast(bf16x8, __builtin_amdgcn_raw_buffer_load_b128(rK, svo, so_, 0)); sk1 = __builtin_bit_cast(bf16x8, __builtin_amdgcn_raw_buffer_load_b128(rK, svo, so_ + 8192, 0)); } while (0)
#define PB_LOADV(it_) do { const int so_ = PB_KB(it_) * 256; sv0 = __builtin_bit_cast(bf16x8, __builtin_amdgcn_raw_buffer_load_b128(rV, svo, so_, 0)); sv1 = __builtin_bit_cast(bf16x8, __builtin_amdgcn_raw_buffer_load_b128(rV, svo, so_ + 8192, 0)); \
        if (MODE == 1 && tid < 64) sf = F2h[PB_KB(it_) + tid]; } while (0)
#define PB_WRITEK(ko_) do { *(LAS bf16x8*)(Kl + (ko_) + kws) = sk0; *(LAS bf16x8*)(Kl + (ko_) + kws + 32 * 256) = sk1; } while (0)
#define PB_WRITEV(bf) do { *(LAS bf16x8*)(Vl + (bf) * SHM_T + vst0) = sv0; *(LAS bf16x8*)(Vl + (bf) * SHM_T + vst1) = sv1; \
        if (MODE == 1 && tid < 64) fbuf[(bf) * 64 + tid] = sf; } while (0)
    PB_LOADK(0); PB_LOADV(0); PB_WRITEK(0); PB_WRITEV(0);
    if (NT > 1) { PB_LOADK(1); PB_WRITEK(SHM_T); }
    LDS_WAIT(); __syncthreads();
    f32x16 o[4];
#pragma unroll
    for (int d = 0; d < 4; ++d) o[d] = (f32x16){0.f, 0.f, 0.f, 0.f, 0.f, 0.f, 0.f, 0.f, 0.f, 0.f, 0.f, 0.f, 0.f, 0.f, 0.f, 0.f};
    float C = 1.0f, m_run = -1e30f, l_run = 0.f;
    f32x16 pA, pB, pdum;
    if (PB_ACT(PB_KB(0) + 32)) qk_half(pA, Kl + 32 * 256, r32, hi, qx, rx);
#define PB_WEIGHTS(MASK_, PC, dq_, fk_) do {                                                                                      \
        if (MODE == 0) { float PS[8], GS[8]; const float tot = sb_step_a<1, MASK_>(PC, pdum, dq_, hi, PS, GS);                      \
            sb_step_b<1>(PC, pdum, C, PS, GS, pa0, pa1, pa2, pa3); C *= tot; }                                                      \
        else { float alpha;                                                                                                        \
            fox_weights<1, MASK_>(PC, pdum, fk_, dq_, m_run, l_run, alpha, pa0, pa1, pa2, pa3);                                     \
            if (__any(alpha < 1.0f)) { if (hi == 0) wsm[r32] = alpha;                                                               \
                _Pragma("unroll") for (int r = 0; r < 16; ++r) { const float al = wsm[crow(r, hi)];                                 \
                    _Pragma("unroll") for (int d = 0; d < 4; ++d) o[d][r] *= al; } } } } while (0)
#define PB_HALF(UP_, PC, PN, hk_, kn_, hkn_) do {                                                                                 \
        const bool actC = PB_ACT(hk_), actN = PB_ACT(hkn_);                                                                        \
        if (actC) { bf16x8 pa0, pa1, pa2, pa3; const int dq = trow - (hk_) - 4 * hi;                                               \
            const LAS f32x4* fk = (const LAS f32x4*)(fbuf + buf * 64 + (UP_ ? 32 : 0) + 4 * hi);                                   \
            if (PB_NM(hk_)) { qk_half(PN, kn_, r32, hi, qx, rx); PB_WEIGHTS(true, PC, dq, fk); }                                        \
            else            { qk_half(PN, kn_, r32, hi, qx, rx); PB_WEIGHTS(false, PC, dq, fk); }                                       \
            pv_half<UP_>(o, vrb + buf * SHM_T, pa0, pa1);                                                                           \
        } else if (actN) qk_half(PN, kn_, r32, hi, qx, rx); } while (0)
    int ko = 0;
    for (int it = 0; it < NT; ++it) {
        const int buf = it & 1, kb = PB_KB(it);
        const int ko1 = (ko == 2 * SHM_T) ? 0 : ko + SHM_T, ko2 = (ko1 == 2 * SHM_T) ? 0 : ko1 + SHM_T;
        if (it + 2 < NT) PB_LOADK(it + 2);
        if (it + 1 < NT) PB_LOADV(it + 1);
        bool skip;
        if (MODE == 0) skip = __all(C < NEG_EPS) != 0; else skip = __all(m_run + fbuf[buf * 64 + 63] > zb) != 0;
        if (!skip) {
        PB_HALF(true, pA, pB, kb + 32, Kl + ko, kb);
        PB_HALF(false, pB, pA, kb, Kl + ko1 + 32 * 256, kb - 32);
        }
        if (it + 2 < NT) PB_WRITEK(ko2);
        if (it + 1 < NT) PB_WRITEV(buf ^ 1);
        if (lane == 0) flg[buf * 8 + wid] = skip ? 1 : 0;
        LDS_WAIT(); __syncthreads();
        { const LAS int* f = flg + buf * 8; if ((f[0] & f[1]) & (f[2] & f[3]) & (f[4] & f[5]) & (f[6] & f[7])) break; }
        ko = ko1;
    }
#undef PB_HALF
#undef PB_WEIGHTS
#undef PB_KB
#undef PB_ACT
#undef PB_NM
#undef PB_LOADK
#undef PB_LOADV
#undef PB_WRITEK
#undef PB_WRITEV
    float rli[16];
    if (MODE == 1) { if (hi == 0) wsm[32 + r32] = l_run;
#pragma unroll
        for (int r = 0; r < 16; ++r) rli[r] = __builtin_amdgcn_rcpf(wsm[32 + crow(r, hi)]); }
#pragma unroll
    for (int hf = 0; hf < 2; ++hf) {
        unsigned gq[8][4];
        const unsigned gb = ((unsigned)(qlo + 4 * hi + 16 * hf) * 128u + (unsigned)r32) * 2u;
#pragma unroll
        for (int r = 0; r < 8; ++r)
#pragma unroll
            for (int d = 0; d < 4; ++d)
                asm volatile("global_load_ushort %0, %1, %2 offset:%3" : "=&v"(gq[r][d]) : "v"(gb), "s"(Gh), "n"(((r & 3) + 8 * (r >> 2)) * 256 + 64 * d) : "memory");
        __builtin_amdgcn_sched_barrier(0);
        asm volatile("s_waitcnt vmcnt(0)" ::: "memory");
        __builtin_amdgcn_sched_barrier(0);
#pragma unroll
        for (int r8 = 0; r8 < 8; ++r8) { const int r = 8 * hf + r8; const unsigned row = (unsigned)(qlo + crow(r, hi));
            const unsigned aoff = (row * 2048u + (unsigned)r32) * 2u;
#pragma unroll
            for (int d = 0; d < 4; ++d) {
                float v = o[d][r]; if (MODE == 1) v *= rli[r];
                v *= __builtin_bit_cast(float, gq[r8][d] << 16);
                const float vn = __shfl_xor(v, 1);
                const unsigned w = cvt_pk_bf16(v, vn);
                if ((r32 & 1) == 0) {
                    if (d == 0) asm volatile("global_store_dword %0, %1, %2" :: "v"(aoff), "v"(w), "s"(Ah) : "memory");
                    else if (d == 1) asm volatile("global_store_dword %0, %1, %2 offset:64" :: "v"(aoff), "v"(w), "s"(Ah) : "memory");
                    else if (d == 2) asm volatile("global_store_dword %0, %1, %2 offset:128" :: "v"(aoff), "v"(w), "s"(Ah) : "memory");
                    else asm volatile("global_store_dword %0, %1, %2 offset:192" :: "v"(aoff), "v"(w), "s"(Ah) : "memory"); } } }
    }
    LDS_WAIT(); __syncthreads();
}

template <int MODE>
__device__ __forceinline__ void sample_unit(LAS char* lds, const bf16* Qs, const float* Kc, const float* Vc, const bf16* Kn, const bf16* Vn, const float* F2, const bf16* Gs, bf16* As, const float* Kmx, int wave_) {
    int tid_ = wave_ * 64 + lane_id(); asm volatile("" : "+v"(tid_));
    const int tid = tid_, wid = __builtin_amdgcn_readfirstlane(tid >> 6), lane = tid & 63, r32 = lane & 31, hi = lane >> 5, qrow = r32 & 15;
    LAS char* Kt = lds + wid * 16384; LAS char* Vt = Kt + 8192;
    LAS float* xch = (LAS float*)(lds + XCH_OFF);
    const int vrb = (int)(unsigned)(size_t)Vt + v_rd_base(lane);
    LAS char* Qb = lds + XCH_OFF + 4096;
    if (tid < 256) { const int r = tid >> 4, c = tid & 15; *(LAS bf16x8*)(Qb + r * 256 + ((c ^ r) << 4)) = *(const bf16x8*)(Qs + (size_t)r * 128 + c * 8); }
    LDS_WAIT(); __syncthreads();
    LAS float* qnt = (LAS float*)(lds + XCH_OFF + 8192 + 1024) + wid * 64;
    LAS float* ktb = (LAS float*)(lds + XCH_OFF + 8192) + wid * 32;
    if (MODE == 1) {
        float qn = 0.f;
#pragma unroll
        for (int c = 0; c < 16; ++c) { const bf16x8 qv = *(LAS bf16x8*)(Qb + qrow * 256 + ((c ^ qrow) << 4));
#pragma unroll
            for (int e = 0; e < 8; ++e) { const float f = bf2f(qv[e]); qn += f * f; } }
        qnt[lane] = sqrtf(qn);
        const int tix = 128 - 8 * ((lane & 15) + 1) + 7 - wid;
        float kn = (tix < KN_TILES) ? Kmx[tix] : 0.f;
        kn = fmaxf(kn, __builtin_bit_cast(float, __builtin_amdgcn_update_dpp(0, __builtin_bit_cast(int, kn), 0x128, 0xf, 0xf, false)));
        kn = fmaxf(kn, __builtin_bit_cast(float, __builtin_amdgcn_update_dpp(0, __builtin_bit_cast(int, kn), 0x124, 0xf, 0xf, false)));
        kn = fmaxf(kn, __builtin_bit_cast(float, __builtin_amdgcn_update_dpp(0, __builtin_bit_cast(int, kn), 0x122, 0xf, 0xf, false)));
        kn = fmaxf(kn, __builtin_bit_cast(float, __builtin_amdgcn_update_dpp(0, __builtin_bit_cast(int, kn), 0x121, 0xf, 0xf, false)));
        if (lane < 16) { ktb[lane] = (tix < KN_TILES) ? sqrtf(kn) * 1.01f : 3.0e38f; ktb[16 + lane] = F2[tix * 32 + 31]; }
    }
    f32x16 o[4];
#pragma unroll
    for (int d = 0; d < 4; ++d) o[d] = (f32x16){0.f, 0.f, 0.f, 0.f, 0.f, 0.f, 0.f, 0.f, 0.f, 0.f, 0.f, 0.f, 0.f, 0.f, 0.f, 0.f};
    const __amdgpu_buffer_rsrc_t rk = mk_rsrc(Kc, PAST * 4096), rv = mk_rsrc(Vc, PAST * 4096);
    const int voff = hi * 4096 + r32 * 16;
    int kwa[4]; const int vw0 = v_st(hi, r32 * 4);
#pragma unroll
    for (int q = 0; q < 4; ++q) kwa[q] = KSWZ(2 * q + hi, r32 * 8);
    float R = 1.0f, m_run = -1e30f, l_run = 0.f;
    f32x4 tk[16];
#define SU_SO(rho_) ((PAST - 256 * (rho_) + 32 * (7 - wid)) * 4096)
#define SU_LOADK(rho_) do { const int so_ = SU_SO(rho_); _Pragma("unroll") for (int i = 0; i < 16; ++i) tk[i] = __builtin_bit_cast(f32x4, __builtin_amdgcn_raw_buffer_load_b128(rk, voff, so_ + i * 8192, 2)); } while (0)
#define SU_LOADV(rho_) do { const int so_ = SU_SO(rho_); _Pragma("unroll") for (int i = 0; i < 16; ++i) tk[i] = __builtin_bit_cast(f32x4, __builtin_amdgcn_raw_buffer_load_b128(rv, voff, so_ + i * 8192, 2)); } while (0)
    f32x4 fr[8];
    if (MODE == 1) {
#pragma unroll
        for (int g = 0; g < 4; ++g) fr[2 * g] = *(const f32x4*)(F2 + (PAST - 256 + 32 * (7 - wid)) + 4 * hi + 8 * g); }
    SU_LOADK(1);
    __builtin_amdgcn_sched_barrier(0);
    bool prev_v = true;
    for (int rho = 0; rho <= PAST / 256; ++rho) {
        const bool valid = (rho > 0) || (wid == 0);
        const int s0 = (rho == 0) ? PAST : PAST - 256 * rho + 32 * (7 - wid);
        f32x16 p0, p1; bf16x8 pa0, pa1, pa2, pa3; float PS[8], GS[8]; float tot = 1.0f; bool need_v = valid, pre_v = false;
        if (valid) {
            if (rho == 0) {
#pragma unroll
                for (int i = 0; i < 4; ++i) { const int idx = lane + 64 * i, row = idx >> 4, ch = idx & 15;
                    const bf16x8 kv = *(const bf16x8*)(Kn + (size_t)row * 128 + ch * 8);
                    const bf16x8 z = (bf16x8){0, 0, 0, 0, 0, 0, 0, 0};
                    *(LAS bf16x8*)(Kt + KSWZ(row, ch * 16)) = kv; *(LAS bf16x8*)(Kt + KSWZ(row + 16, ch * 16)) = z; }
            } else {
#pragma unroll
                for (int i = 0; i < 16; ++i) { u32x2 w; w.x = cvt_pk_bf16(tk[i][0], tk[i][1]); w.y = cvt_pk_bf16(tk[i][2], tk[i][3]); *(LAS u32x2*)(Kt + kwa[i & 3] + (i >> 2) * 2048) = w; }
                __builtin_amdgcn_sched_barrier(0);
                pre_v = (MODE == 0) || prev_v;
                if (pre_v) SU_LOADV(rho);
                __builtin_amdgcn_sched_barrier(0);
            }
            qkt_qlds(p0, Kt, Qb, r32, hi, qrow);
            const int dq = qrow - 4 * hi;
            if (MODE == 0) { if (rho == 0) tot = sb_step_a<1, true>(p0, p1, dq, hi, PS, GS); else tot = sb_step_a<1, false>(p0, p1, dq, hi, PS, GS); }
            else { float alpha, ps;
                if (rho == 0) ps = fox_weights<1, true>(p0, p1, (const f32x4*)(F2 + s0 + 4 * hi), dq, m_run, l_run, alpha, pa0, pa1, pa2, pa3);
                else { ps = fox_weights<1, false>(p0, p1, (const f32x4*)fr, dq, m_run, l_run, alpha, pa0, pa1, pa2, pa3);
                    if (rho < PAST / 256) {
#pragma unroll
                        for (int g = 0; g < 4; ++g) fr[2 * g] = *(const f32x4*)(F2 + s0 - 256 + 4 * hi + 8 * g); } }
                need_v = __any(ps != 0.0f) != 0;
                if (__any(alpha < 1.0f)) { LAS float* al = xch + 768 + wid * 32; if (hi == 0) al[r32] = alpha;
#pragma unroll
                    for (int r = 0; r < 16; ++r) { const float a_ = al[crow(r, hi)];
#pragma unroll
                        for (int d = 0; d < 4; ++d) o[d][r] *= a_; } }
            }
        }
        if (MODE == 0) {
            LAS float* xr = xch + (rho & 1) * 256;
            if (hi == 0) xr[wid * 32 + r32] = tot;
            LDS_WAIT(); __builtin_amdgcn_s_barrier(); asm volatile("" ::: "memory");
            float Cin = R;
#pragma unroll
            for (int w = 0; w < 8; ++w) { const float tw = xr[w * 32 + r32]; if (w < wid) Cin *= tw; R *= tw; }
            if (valid) sb_step_b<1>(p0, p1, Cin, PS, GS, pa0, pa1, pa2, pa3);
        }
        const bool more = (rho < PAST / 256) && !(MODE == 0 && rho > 0 && __all(R < NEG_EPS)) && !(MODE == 1 && rho > 0 && __all(qnt[lane] * ktb[rho & 15] - ktb[16 + (rho & 15)] - m_run < -NEG_BITS));
        if (need_v) {
            if (rho == 0) {
#pragma unroll
                for (int i = 0; i < 4; ++i) { const int idx = lane + 64 * i, row = idx >> 4, ch = idx & 15;
                    const bf16x8 vv = *(const bf16x8*)(Vn + (size_t)row * 128 + ch * 8);
                    const bf16x8 z = (bf16x8){0, 0, 0, 0, 0, 0, 0, 0};
                    *(LAS bf16x8*)(Vt + v_st(row, ch * 8)) = vv; *(LAS bf16x8*)(Vt + v_st(row + 16, ch * 8)) = z; }
            } else {
                if (!pre_v) SU_LOADV(rho);
#pragma unroll
                for (int i = 0; i < 16; ++i) { u32x2 w; w.x = cvt_pk_bf16(tk[i][0], tk[i][1]); w.y = cvt_pk_bf16(tk[i][2], tk[i][3]); *(LAS u32x2*)(Vt + vw0 + ((i >> 1) & 1) * 2048 + (i & 1) * 128 + (i >> 3) * 4096 + ((i >> 2) & 1) * 256) = w; }
            }
            __builtin_amdgcn_sched_barrier(0);
            if (rho > 0 && more) SU_LOADK(rho + 1);
            __builtin_amdgcn_sched_barrier(0);
            pv_tile<1>(o, vrb, pa0, pa1, pa2, pa3);
        } else if (rho > 0 && more) SU_LOADK(rho + 1);
        if (rho > 0) prev_v = need_v;
        if (!more) break;
    }
#undef SU_SO
#undef SU_LOADK
#undef SU_LOADV
    LDS_WAIT(); __syncthreads();
    int tid2 = wave_ * 64 + lane_id(); asm volatile("" : "+v"(tid2));
    { const int l2 = tid2 & 63, c2 = l2 & 31, h2 = l2 >> 5;
    if (MODE == 1 && h2 == 0 && c2 < 16) { xch[512 + wid * 16 + c2] = m_run; xch[640 + wid * 16 + c2] = l_run; }
    LAS float* Op = (LAS float*)(lds + wid * 16384) + 4 * h2 * 128 + c2;
#pragma unroll
    for (int d = 0; d < 4; ++d)
#pragma unroll
        for (int r = 0; r < 8; ++r) Op[((r & 3) + 8 * (r >> 2)) * 128 + d * 32] = o[d][r]; }
    LDS_WAIT(); __syncthreads();
    {
        const int row = tid2 >> 5, col = (tid2 & 31) * 4;
        f32x4 num = (f32x4){0.f, 0.f, 0.f, 0.f}; float den = 0.f, M = -1e30f;
        const LAS float* xm = xch + 512 + row;
        if (MODE == 1) {
#pragma unroll 1
            for (int w = 0; w < 8; ++w) M = fmaxf(M, xm[w * 16]); }
        const LAS char* opb = lds + (row * 128 + col) * 4;
#pragma unroll 1
        for (int w = 0; w < 8; ++w) { const f32x4 v = *(const LAS f32x4*)(opb + w * 16384);
            if (MODE == 1) { const float f = __builtin_amdgcn_exp2f(xm[w * 16] - M); num += v * f; den += f * xm[128 + w * 16]; } else num += v; }
        if (MODE == 1) num = num * (1.0f / den);
        const u32x2 gw = *(const u32x2*)(Gs + (size_t)row * 128 + col);
        u32x2 ow; ow.x = cvt_pk_bf16(num[0] * bf_lo(gw.x), num[1] * bf_hi(gw.x)); ow.y = cvt_pk_bf16(num[2] * bf_lo(gw.y), num[3] * bf_hi(gw.y));
        *(u32x2*)(As + (size_t)row * 2048 + col) = ow;
    }
    LDS_WAIT(); __syncthreads();
}
}

struct Args { const float* in[15]; float* out; unsigned char* ws; int ph_lo, ph_hi, li, pad; };

__global__ void __launch_bounds__(512, 2) fwd(Args args) {
    extern __shared__ __attribute__((aligned(16))) unsigned char lds_raw[];
    LAS unsigned char* lds = (LAS unsigned char*)lds_raw;
    const int wave = __builtin_amdgcn_readfirstlane((int)threadIdx.x >> 6);
#define lane (lane_id())
#define tid (wave * 64 + lane_id())
    const int G = gridDim.x;
    Ptrs P;
    P.xp = args.in[0]; P.xs = args.in[1]; P.csbk = args.in[2]; P.csbv = args.in[3]; P.cfxk = args.in[4]; P.cfxv = args.in[5]; P.cflf = args.in[6]; P.normw = args.in[7];
    P.win = args.in[8]; P.bfor = args.in[9]; P.qnw = args.in[10]; P.knw = args.in[11]; P.wbsb = args.in[12]; P.wbfx = args.in[13]; P.wout = args.in[14];
    P.out = args.out; P.ws = args.ws;
    volatile LAS unsigned* MISC = (volatile LAS unsigned*)(lds + MISC_OFF);
    if (tid < 64) MISC[tid] = 0u;
    __syncthreads();
    unsigned* ctl = (unsigned*)(P.ws + WS_CTL);
    XcdBarrier bar; bar.bar = ctl + args.li * 4096; bar.x = 0; bar.st = nullptr; bar.wave = wave;
    if (N_LAUNCHES != N_PHASES) bar = xcd_barrier_post(ctl + args.li * 4096, MISC + 8, wave);
    const int lo = args.ph_lo, hi_ = args.ph_hi;
#define IN(k) (lo <= (k) && (k) < hi_)
#define BOTH(k) (IN(k) && IN((k) + 1))
#define GRID_BAR() do { if (N_LAUNCHES != N_PHASES) xcd_barrier(bar); } while (0)

    if (IN(0)) { p0_prologue(P, lds, blockIdx.x * 8 + wave, G * 8, wave, lane, tid);
        if (PROBE_DOUBLE == 0) { __syncthreads(); p0_prologue(P, lds, blockIdx.x * 8 + wave, G * 8, wave, lane, tid); }
        if (BOTH(0)) GRID_BAR(); }

    if (IN(1)) {
        pg8::Gemm g{(const bf16*)(P.ws + WS_H), (const bf16*)(P.ws + WS_WIN), TT, NPROJ, DM};
        pg8::StaticOrder S; S.init(TT, NPROJ, G, (int)blockIdx.x, WGM_P1);
        pg8::EpiInProj E{P.ws, P.out, P.qnw, P.knw, (LAS float*)(lds + XCH_OFF)};
        pg8::gemm_phase<pg8::EpiInProj, pg8::StaticOrder, true, true>(lds, g, S, E, wave);
        if (PROBE_DOUBLE == 1) { GRID_BAR(); pg8::gemm_phase<pg8::EpiInProj, pg8::StaticOrder, true, true>(lds, g, S, E, wave); }
        { const int ex = ((TT / 256) * (NPROJ / 256)) % G, nside = (ex > 0 && ex < G) ? G - ex : G, sid = (ex > 0 && ex < G) ? (int)blockIdx.x - ex : (int)blockIdx.x;
          if (sid >= 0) { __syncthreads();
              for (int id = sid; id < 8 + NBAT * NH; id += nside) scan_seq(P, lds, id, tid);
              p1_side_weights(P, lds, sid * 8 + wave, nside * 8, wave, lane);
              p1_side_knorm(P, sid * 8 + wave, nside * 8, lane); } }
        if (BOTH(1)) GRID_BAR();
    }

    if (IN(2)) {
        const bf16* ACT = (const bf16*)(P.ws + WS_ACT); constexpr size_t AS = ACT_STRIDE / 2;
        bf16* ACAT = (bf16*)(P.ws + WS_ACAT);
        LAS int* slot = (LAS int*)(lds + MISC_OFF + 64);
        float zb;
        { float a = fmaxf(fabsf(P.qnw[lane]), fabsf(P.qnw[lane + 64])), b = fmaxf(fabsf(P.knw[lane]), fabsf(P.knw[lane + 64]));
#pragma unroll
          for (int o = 1; o < 64; o <<= 1) { a = fmaxf(a, __shfl_xor(a, o)); b = fmaxf(b, __shfl_xor(b, o)); }
          zb = __builtin_bit_cast(float, __builtin_amdgcn_readfirstlane(__builtin_bit_cast(unsigned, 128.0f * a * b * QSCALE * 1.02f + NEG_BITS))); }
#define DQ_NEXT(q, var) do { if (tid == 0) *slot = (int)__hip_atomic_fetch_add(ctl + CW_QUEUE + 64 * (q), 1u, __ATOMIC_RELAXED, __HIP_MEMORY_SCOPE_AGENT); LDS_WAIT(); __syncthreads(); var = *slot; __syncthreads(); } while (0)
        { constexpr int qo = 0;
        if ((((int)blockIdx.x >> 3) & 1) == 0) { const int u = ((int)blockIdx.x >> 4) * 8 + ((int)blockIdx.x & 7);
            const int b = u >> 3, h = u & 7;
            const size_t ro = ((size_t)h * TT + TP + 16 * b) * 128, co = ((size_t)b * PAST * NH + h) * HD;
            att::sample_unit<1>((LAS char*)lds, ACT + A_QFX * AS + ro, P.cfxk + co, P.cfxv + co, ACT + A_KFX * AS + ro, ACT + A_VFX * AS + ro,
                                (const float*)(P.ws + WS_F2S) + (size_t)(b * 8 + h) * KT, ACT + A_GFX * AS + ro, ACAT + (size_t)(TP + 16 * b) * 2048 + 1024 + 128 * h, (const float*)(P.ws + WS_KMX) + (size_t)(b * 8 + h) * 128, wave); }
#define DQ_HEADS(QB, cur, u, hsel) do { if (wave == 0) { int hs_ = (cur), uu_ = 32;                                                                              \
            for (;;) { unsigned v_ = 0u; if (lane == 0) v_ = __hip_atomic_fetch_add(ctl + CW_QUEUE + 64 * ((QB) + hs_), 1u, __ATOMIC_RELAXED, __HIP_MEMORY_SCOPE_AGENT);   \
                uu_ = __builtin_amdgcn_readfirstlane((int)v_); if (uu_ < 32) break;                                                                                 \
                unsigned c_ = 32u; if (lane < 8) c_ = __hip_atomic_load(ctl + CW_QUEUE + 64 * ((QB) + lane), __ATOMIC_RELAXED, __HIP_MEMORY_SCOPE_AGENT);               \
                const unsigned m_ = (unsigned)__ballot(c_ < 32u) & 0xffu; if (m_ == 0u) { hs_ = -1; break; }                                                       \
                const unsigned rot_ = ((m_ >> home) | (m_ << (8 - home))) & 0xffu; hs_ = (home + __builtin_ctz(rot_)) & 7; }                                       \
            if (lane == 0) { slot[0] = uu_; slot[1] = hs_; } }                                                                                                     \
        LDS_WAIT(); __syncthreads(); u = slot[0]; hsel = slot[1]; __syncthreads(); } while (0)
        const int home = (int)blockIdx.x & 7;
        { int cur = home;
          for (;;) { int u, h; DQ_HEADS(16, cur, u, h); if (h < 0) break; cur = h; const size_t ho = (size_t)h * TT * 128;
              att::prompt_block<1>((LAS char*)lds, ACT + A_QFX * AS + ho, ACT + A_KFX * AS + ho, ACT + A_VFX * AS + ho, (const float*)(P.ws + WS_F2P) + (size_t)h * TP, ACT + A_GFX * AS + ho, ACAT + 1024 + 128 * h, 31 - u, zb, wave); } }
        { int cur = home;
          for (;;) { int u, h; DQ_HEADS(24, cur, u, h); if (h < 0) break; cur = h; const size_t ho = (size_t)h * TT * 128;
              att::prompt_block<0>((LAS char*)lds, ACT + A_QSB * AS + ho, ACT + A_KSB * AS + ho, ACT + A_VSB * AS + ho, (const float*)(P.ws + WS_F2P), ACT + A_GSB * AS + ho, ACAT + 128 * h, 31 - u, zb, wave); } }
#undef DQ_HEADS
        for (;;) { int u; DQ_NEXT(qo + 3, u); if (u >= NBAT * NH) break;
            const int b = u >> 3, h = u & 7;
            const size_t ro = ((size_t)h * TT + TP + 16 * b) * 128, co = ((size_t)b * PAST * NH + h) * HD;
            att::sample_unit<0>((LAS char*)lds, ACT + A_QSB * AS + ro, P.csbk + co, P.csbv + co, ACT + A_KSB * AS + ro, ACT + A_VSB * AS + ro,
                                (const float*)(P.ws + WS_F2S), ACT + A_GSB * AS + ro, ACAT + (size_t)(TP + 16 * b) * 2048 + 128 * h, nullptr, wave); }
        }
#undef DQ_NEXT
        if (BOTH(2)) GRID_BAR();
    }
    if (IN(3)) {
        pg8::Gemm g{(const bf16*)(P.ws + WS_ACAT), (const bf16*)(P.ws + WS_WB), TP, DM, DM};
        pg8::StaticOrder S; S.init(TP, DM, G, (int)blockIdx.x, WGM_P3);
        for (int u = blockIdx.x; u < 256; u += G)
            mini_gemm<0>(lds, (const bf16*)(P.ws + WS_ACAT) + (size_t)TP * 2048, (const bf16*)(P.ws + WS_WB), u, wave, lane, tid, (const bf16*)(P.ws + WS_MSIG) + (size_t)TP * 4096, (bf16*)(P.ws + WS_MRG) + (size_t)TP * 2048, nullptr, nullptr);
        pg8::EpiMerge E{(const bf16*)(P.ws + WS_MSIG), (bf16*)(P.ws + WS_MRG)};
        pg8::gemm_phase<pg8::EpiMerge, pg8::StaticOrder, true, true>(lds, g, S, E, wave);
        if (PROBE_DOUBLE == 3) { GRID_BAR(); pg8::gemm_phase<pg8::EpiMerge, pg8::StaticOrder, true, true>(lds, g, S, E, wave); }
        if (BOTH(3)) GRID_BAR();
    }

    if (IN(4)) {
        pg8::Gemm g{(const bf16*)(P.ws + WS_MRG), (const bf16*)(P.ws + WS_WO), TP, DM, DM};
        pg8::StaticOrder S; S.init(TP, DM, G, (int)blockIdx.x, WGM_P4);
        for (int u = blockIdx.x; u < 256; u += G)
            mini_gemm<1>(lds, (const bf16*)(P.ws + WS_MRG) + (size_t)TP * 2048, (const bf16*)(P.ws + WS_WO), u, wave, lane, tid, nullptr, nullptr, P.xs, P.out + O_YS);
        pg8::EpiOut E{P.xp, P.xs, P.out};
        pg8::gemm_phase<pg8::EpiOut, pg8::StaticOrder, true, true>(lds, g, S, E, wave);
    }
#undef IN
#undef BOTH
#undef GRID_BAR
#undef lane
#undef tid
}

extern "C" void kernel_launch(void* const* d_in, const int* in_sizes, int n_in, void* d_out, int out_size, void* d_ws, size_t ws_size, hipStream_t stream) {
    static int grid = 0;
    if (grid == 0) {
        if (n_in != 15 || out_size != (int)O_END || ws_size < WS_END) { fprintf(stderr, "kernel_launch: unexpected shapes (n_in %d, out %d, ws %zu)\n", n_in, out_size, ws_size); grid = -1; return; }
        int dev = 0, cus = 0, per_cu = 0;
        if (hipGetDevice(&dev) != hipSuccess || hipDeviceGetAttribute(&cus, hipDeviceAttributeMultiprocessorCount, dev) != hipSuccess) { grid = -1; return; }
        if (hipFuncSetAttribute((const void*)fwd, hipFuncAttributeMaxDynamicSharedMemorySize, LDS_BYTES) != hipSuccess) { fprintf(stderr, "kernel_launch: hipFuncSetAttribute failed\n"); grid = -1; return; }
        if (hipOccupancyMaxActiveBlocksPerMultiprocessor(&per_cu, (const void*)fwd, 512, LDS_BYTES) != hipSuccess || per_cu < 1) fprintf(stderr, "kernel_launch: occupancy query reports %d\n", per_cu);
        (void)hipGetLastError();
        grid = cus;
    }
    if (grid < 0) return;
    if (hipMemsetAsync((char*)d_ws + WS_CTL, 0, CTL_ZERO_BYTES, stream) != hipSuccess) return;
    Args a{};
    for (int i = 0; i < 15; ++i) a.in[i] = (const float*)d_in[i];
    a.out = (float*)d_out; a.ws = (unsigned char*)d_ws;
    for (int li = 0; li < N_LAUNCHES; ++li) {
        if (N_LAUNCHES == N_PHASES) { a.ph_lo = li; a.ph_hi = li + 1; } else { a.ph_lo = 0; a.ph_hi = N_PHASES; }
        a.li = li; a.pad = 0;
        hipLaunchKernelGGL(fwd, dim3(grid), dim3(512), LDS_BYTES, stream, a);
        const hipError_t le = hipPeekAtLastError();
        if (le != hipSuccess) { fprintf(stderr, "kernel_launch: launch %d failed: %s\n", li, hipGetErrorName(le)); break; }
    }
}
```

```cpp
#include <hip/hip_runtime.h>
#include <cstdio>
#include <cstdint>

#ifndef MK_N_LAUNCHES
#define MK_N_LAUNCHES 1
#endif
#ifndef PROBE_DOUBLE
#define PROBE_DOUBLE -1
#endif
constexpr int N_PHASES = 5;
constexpr int N_LAUNCHES = MK_N_LAUNCHES;

#define GAS __attribute__((address_space(1)))
#define LAS __attribute__((address_space(3)))
typedef unsigned short bf16;
typedef short bf16x8 __attribute__((ext_vector_type(8)));
typedef short s16x4 __attribute__((ext_vector_type(4)));
typedef float f32x4 __attribute__((ext_vector_type(4)));
typedef float f32x16 __attribute__((ext_vector_type(16)));
typedef unsigned u32x4 __attribute__((ext_vector_type(4)));
typedef unsigned u32x2 __attribute__((ext_vector_type(2)));

constexpr int DM = 2048, TP = 8192, NBAT = 16, NSEQ = 16, PAST = 4096, NH = 8, HD = 128, WB = 1024;
constexpr int TS = NBAT * NSEQ;
constexpr int TT = TP + TS;
constexpr int DIN = 12296, NPROJ = 12288;
constexpr int KT = PAST + NSEQ;
constexpr float RMS_EPS = 1e-6f;
constexpr float LOG2E = 1.4426950408889634f;
constexpr float QSCALE = 0.08838834764831845f * 1.4426950408889634f;

constexpr size_t O_YP = 0, O_YS = 16777216, O_PSBK = 17301504, O_PSBV = 25690112, O_PFXK = 34078720, O_PFXV = 42467328, O_PLF = 50855936,
                 O_SSBK = 50921472, O_SSBV = 51183616, O_SFXK = 51445760, O_SFXV = 51707904, O_SLF = 51970048, O_END = 51972096;

constexpr size_t MiB = 1u << 20;
constexpr size_t WS_CTL = 0, CTL_ZERO_BYTES = 1 * MiB;
constexpr int CW_QUEUE = 32768;
constexpr size_t WS_WIN = 2 * MiB;
constexpr size_t WS_WB = 50 * MiB;
constexpr size_t WS_WO = 58 * MiB;
constexpr size_t WS_H = 66 * MiB;
constexpr size_t WS_ACT = 99 * MiB, ACT_STRIDE = 17 * MiB;
constexpr size_t WS_MSIG = 235 * MiB;
constexpr size_t WS_ACAT = 301 * MiB;
constexpr size_t WS_MRG = 334 * MiB;
constexpr size_t WS_F2P = 367 * MiB;
constexpr size_t WS_F2S = 368 * MiB;
constexpr size_t WS_KMX = 372 * MiB;
constexpr size_t WS_END = 373 * MiB;
constexpr int KN_TILES = 96;
constexpr int WGM_P1 = 3, WGM_P3 = 4, WGM_P4 = 4;
constexpr float NEG_BITS = 64.0f, NEG_EPS = 5.0e-20f;
enum { A_QSB = 0, A_KSB, A_VSB, A_GSB, A_QFX, A_KFX, A_VFX, A_GFX };

constexpr int LDS_BYTES = 163840;
constexpr int XCH_OFF = 131072;
constexpr int MISC_OFF = 163328;

#define LDS_WAIT() asm volatile("s_waitcnt lgkmcnt(0)" ::: "memory")
#define VM_WAIT() asm volatile("s_waitcnt vmcnt(0)" ::: "memory")
__device__ __forceinline__ unsigned cvt_pk_bf16(float lo, float hi) { unsigned r; asm volatile("v_cvt_pk_bf16_f32 %0, %1, %2" : "=v"(r) : "v"(lo), "v"(hi)); return r; }
__device__ __forceinline__ float bf_lo(unsigned w) { return __builtin_bit_cast(float, w << 16); }
__device__ __forceinline__ float bf_hi(unsigned w) { return __builtin_bit_cast(float, w & 0xffff0000u); }
__device__ __forceinline__ float bf2f(bf16 v) { return __builtin_bit_cast(float, (unsigned)v << 16); }
__device__ __forceinline__ float fast_sigmoid(float v) { return __builtin_amdgcn_rcpf(1.0f + __builtin_amdgcn_exp2f(-v * LOG2E)); }

__device__ __forceinline__ int lane_id() { int r; asm volatile("v_mbcnt_lo_u32_b32 %0, -1, 0\n\tv_mbcnt_hi_u32_b32 %0, -1, %0" : "=v"(r)); return r; }
namespace pg8 {
constexpr int BM = 256, BK = 64, HALF = 128, HTB = HALF * BK * 2, STAGE_BYTES = 8 * HTB, NXCD = 8;
__host__ __device__ __forceinline__ int lds_byte(int r, int c) { const int st = (r >> 4) * 2 + (c >> 5), rr = r & 15, cc = c & 31, ob = rr * 64 + cc * 2; return st * 1024 + (ob ^ (((ob >> 9) & 1) << 5)); }
__host__ __device__ __forceinline__ void stage_rc(int b, int& R, int& C) { const int st = b / 1024, sb = b % 1024, swz = sb ^ (((sb >> 9) & 1) << 5); R = (st >> 1) * 16 + swz / 64; C = (st & 1) * 32 + (swz % 64) / 2; }
__host__ __device__ __forceinline__ int perm32(int rho) { const int n = rho >> 4, i = rho & 15; return 8 * (i >> 2) + 4 * n + (i & 3); }

struct Unit { int pm, pn; };
struct Gemm { const bf16* A; const bf16* Bt; int M, N, K; };

struct StaticOrder {
    int nM, nN, nwg, G, c, WGM;
    __host__ __device__ void init(int M, int N, int G_, int c_, int wgm_) { nM = M / BM; nN = N / BM; nwg = nM * nN; G = G_; c = c_; WGM = wgm_; }
    __host__ __device__ bool next(int i, Unit& u) const {
        const long L = (long)i * G + c; if (L >= nwg) return false;
        int wgid = (int)L; { const int q = nwg / NXCD, r = nwg % NXCD, xcd = wgid % NXCD, off = wgid / NXCD; wgid = (xcd < r ? xcd * (q + 1) : r * (q + 1) + (xcd - r) * q) + off; }
        const int nig = WGM * nN, gid = wgid / nig, fm = gid * WGM, gsz = (nM - fm) < WGM ? (nM - fm) : WGM;
        u.pm = fm + ((wgid % nig) % gsz); u.pn = (wgid % nig) / gsz; return true;
    }
    __device__ __forceinline__ void a_ready(const Unit&) const {}
    __device__ __forceinline__ void done(const Unit&) const {}
};


struct EpiInProj {
    static constexpr bool PERM = true, AFTER_DRAIN = false, MIDK = false;
    unsigned char* ws; float* out; const float* qnw; const float* knw; LAS float* xch;
    __device__ __forceinline__ void operator()(f32x4 (&acc)[2][2][4][2], const Unit& u, int wr, int wc, int fr, int fq) const {
        const int grp = u.pn >> 2;
        const int rowl0 = wr * 64 + fr, colq = wc * 32 + 8 * fq;
        const bool sample = (u.pm >= TP / 256);
        if (grp == 4 || grp == 5) {
            const float* nw = (grp == 4) ? qnw : knw;
            const f32x4 w0 = *(const f32x4*)(nw + colq), w1 = *(const f32x4*)(nw + colq + 4);
#pragma unroll
            for (int ai = 0; ai < 2; ++ai)
#pragma unroll
                for (int m = 0; m < 4; ++m)
#pragma unroll
                    for (int bj = 0; bj < 2; ++bj) {
                        const f32x4 a = acc[ai][bj][m][0], b = acc[ai][bj][m][1];
                        float s = (a[0] * a[0] + a[1] * a[1]) + (a[2] * a[2] + a[3] * a[3]) + (b[0] * b[0] + b[1] * b[1]) + (b[2] * b[2] + b[3] * b[3]);
                        s += __shfl_xor(s, 16); s += __shfl_xor(s, 32);
                        if (fq == 0) xch[(ai * 128 + rowl0 + 16 * m) * 8 + bj * 4 + wc] = s;
                    }
            LDS_WAIT(); __builtin_amdgcn_s_barrier(); asm volatile("" ::: "memory");
            const float post = (grp == 4) ? QSCALE : 1.0f;
#pragma unroll
            for (int ai = 0; ai < 2; ++ai)
#pragma unroll
                for (int m = 0; m < 4; ++m)
#pragma unroll
                    for (int bj = 0; bj < 2; ++bj) {
                        const f32x4 t = *(const LAS f32x4*)(xch + (ai * 128 + rowl0 + 16 * m) * 8 + bj * 4);
                        const float tot = (t[0] + t[1]) + (t[2] + t[3]);
                        const float rs = __builtin_amdgcn_rsqf(tot * (1.0f / 128.0f) + RMS_EPS) * post;
                        acc[ai][bj][m][0] = acc[ai][bj][m][0] * rs * w0; acc[ai][bj][m][1] = acc[ai][bj][m][1] * rs * w1;
                    }
        }
        bf16* bdst; int bld; int bcol0; float* fdst = nullptr; int mode = 0;
        if (grp < 8) { bdst = (bf16*)(ws + WS_ACT + (size_t)grp * ACT_STRIDE); bld = 1024; bcol0 = (u.pn & 3) * 256;
            if (grp == 0) mode = 1; else if (grp == 3 || grp == 7) mode = 2;
            if (grp == 1) fdst = out + (sample ? O_SSBK : O_PSBK); else if (grp == 2) fdst = out + (sample ? O_SSBV : O_PSBV);
            else if (grp == 5) fdst = out + (sample ? O_SFXK : O_PFXK); else if (grp == 6) fdst = out + (sample ? O_SFXV : O_PFXV);
        } else { bdst = (bf16*)(ws + WS_MSIG); bld = 4096; bcol0 = (u.pn - 32) * 256; mode = 3; }
        const int frow_off = sample ? TP : 0;
#pragma unroll
        for (int ai = 0; ai < 2; ++ai)
#pragma unroll
            for (int m = 0; m < 4; ++m) {
                const int row = u.pm * 256 + ai * 128 + rowl0 + 16 * m;
#pragma unroll
                for (int bj = 0; bj < 2; ++bj) {
                    f32x4 v0 = acc[ai][bj][m][0], v1 = acc[ai][bj][m][1];
                    const int col = bcol0 + bj * 128 + colq;
                    if (fdst) { float* fp = fdst + (size_t)(row - frow_off) * 1024 + col; *(f32x4*)fp = v0; *(f32x4*)(fp + 4) = v1; }
                    if (mode == 1) { v0 = v0 * QSCALE; v1 = v1 * QSCALE; }
                    else if (mode == 2) {
#pragma unroll
                        for (int j = 0; j < 4; ++j) { v0[j] = v0[j] * fast_sigmoid(v0[j]); v1[j] = v1[j] * fast_sigmoid(v1[j]); } }
                    else if (mode == 3) {
#pragma unroll
                        for (int j = 0; j < 4; ++j) { v0[j] = fast_sigmoid(v0[j]); v1[j] = fast_sigmoid(v1[j]); } }
                    u32x4 w; w.x = cvt_pk_bf16(v0[0], v0[1]); w.y = cvt_pk_bf16(v0[2], v0[3]); w.z = cvt_pk_bf16(v1[0], v1[1]); w.w = cvt_pk_bf16(v1[2], v1[3]);
                    if (grp < 8) *(u32x4*)(bdst + ((size_t)(((u.pn & 3) * 2 + bj) * TT + row)) * 128 + colq) = w;
                    else if (sample) *(u32x4*)(bdst + (size_t)row * bld + col) = w;
                    else *(u32x4*)(bdst + (size_t)(u.pm * 16 + (u.pn - 32)) * 65536 + (size_t)((ai * 4 + m) * 2 + bj) * 4096 + (size_t)(((wr * 4 + wc) * 64 + fq * 16 + fr) * 8)) = w;
                }
            }
    }
};

struct EpiMerge {
    static constexpr bool PERM = true, AFTER_DRAIN = false, MIDK = true;
    const bf16* msig; bf16* mrg;
    template <bool FINAL>
    __device__ __forceinline__ void apply(f32x4 (&acc)[2][2][4][2], const Unit& u, int wr, int wc, int fr, int fq) const {
        const int rowl0 = wr * 64 + fr, colq = wc * 32 + 8 * fq;
        int pm_ = u.pm; asm volatile("" : "+s"(pm_));
#pragma unroll
        for (int ai = 0; ai < 2; ++ai)
#pragma unroll
            for (int m = 0; m < 4; ++m) {
                const int row = pm_ * 256 + ai * 128 + rowl0 + 16 * m;
#pragma unroll
                for (int bj = 0; bj < 2; ++bj) {
                    const int col = u.pn * 256 + bj * 128 + colq;
                    const bf16* gt = msig + (size_t)(pm_ * 16 + u.pn) * 65536 + (size_t)((ai * 4 + m) * 2 + bj) * 4096 + (size_t)(((wr * 4 + wc) * 64 + fq * 16 + fr) * 8);
                    const u32x4 gf = *(const u32x4*)(gt + (size_t)8 * 65536);
                    float f[8] = {bf_lo(gf.x), bf_hi(gf.x), bf_lo(gf.y), bf_hi(gf.y), bf_lo(gf.z), bf_hi(gf.z), bf_lo(gf.w), bf_hi(gf.w)};
#pragma unroll
                    for (int j = 0; j < 8; ++j) f[j] = fmaxf(f[j], 1e-30f);
                    if (!FINAL) {
                        const u32x4 gs = *(const u32x4*)gt;
                        const float s[8] = {bf_lo(gs.x), bf_hi(gs.x), bf_lo(gs.y), bf_hi(gs.y), bf_lo(gs.z), bf_hi(gs.z), bf_lo(gs.w), bf_hi(gs.w)};
#pragma unroll
                        for (int j = 0; j < 4; ++j) { acc[ai][bj][m][0][j] *= s[j] * __builtin_amdgcn_rcpf(f[j]); acc[ai][bj][m][1][j] *= s[4 + j] * __builtin_amdgcn_rcpf(f[4 + j]); }
                    } else {
                        const f32x4 v0 = acc[ai][bj][m][0], v1 = acc[ai][bj][m][1];
                        u32x4 w; w.x = cvt_pk_bf16(v0[0] * f[0], v0[1] * f[1]); w.y = cvt_pk_bf16(v0[2] * f[2], v0[3] * f[3]);
                        w.z = cvt_pk_bf16(v1[0] * f[4], v1[1] * f[5]); w.w = cvt_pk_bf16(v1[2] * f[6], v1[3] * f[7]);
                        *(u32x4*)(mrg + (size_t)row * 2048 + col) = w;
                    }
                    asm volatile("" ::: "memory");
                }
            }
    }
    __device__ __forceinline__ void mid(f32x4 (&acc)[2][2][4][2], const Unit& u, int wr, int wc, int fr, int fq) const { apply<false>(acc, u, wr, wc, fr, fq); }
    __device__ __forceinline__ void operator()(f32x4 (&acc)[2][2][4][2], const Unit& u, int wr, int wc, int fr, int fq) const { apply<true>(acc, u, wr, wc, fr, fq); }
};

struct EpiOut {
    static constexpr bool PERM = false, AFTER_DRAIN = false, MIDK = false;
    const float* xp; const float* xs; float* y;
    __device__ __forceinline__ void operator()(f32x4 (&acc)[2][2][4][2], const Unit& u, int wr, int wc, int fr, int fq) const {
        const int rowl0 = wr * 64 + fr, colq = wc * 32 + 4 * fq;
#pragma unroll
        for (int ai = 0; ai < 2; ++ai)
#pragma unroll
            for (int m = 0; m < 4; ++m) {
                const int row = u.pm * 256 + ai * 128 + rowl0 + 16 * m;
                const float* xr = (row < TP) ? xp + (size_t)row * DM : xs + (size_t)(row - TP) * DM;
                float* yr = y + (size_t)row * DM;
#pragma unroll
                for (int bj = 0; bj < 2; ++bj)
#pragma unroll
                    for (int n = 0; n < 2; ++n) { const int c = u.pn * 256 + bj * 128 + colq + 16 * n; *(f32x4*)(yr + c) = acc[ai][bj][m][n] + __builtin_nontemporal_load((const f32x4*)(xr + c)); }
                asm volatile("" ::: "memory");
            }
    }
};

template <class Epi, class Sched, bool ALIGN_EPI = false, bool SP2 = false>
__device__ __forceinline__ void gemm_phase(LAS unsigned char* lds, const Gemm g, const Sched& S, const Epi& E, int wave_) {
    const int wid = wave_, lane = lane_id(), tid = wid * 64 + lane, wr = wid >> 2, wc = wid & 3, fr = lane & 15, fq = lane >> 4;
    const int K = g.K, nt = K / BK;
    unsigned voffA[2], voffB[2];
#pragma unroll
    for (int i = 0; i < 2; ++i) { int R, C; stage_rc(tid * 16 + i * 8192, R, C); const int Rb = Epi::PERM ? ((R & ~31) + perm32(R & 31)) : R;
        voffA[i] = (unsigned)(R * K + C) * 2u; voffB[i] = (unsigned)(Rb * K + C) * 2u; }
    const size_t kstep = (size_t)(BK * 2);
    const size_t hstep = (size_t)HALF * K * 2;
    const size_t tstep = 2 * hstep;
    const unsigned ldsw = (unsigned)wid * 1024u;
    const int aoff = lds_byte(wr * 64 + fr, fq * 8), boff = lds_byte(wc * 32 + fr, fq * 8);
#define PG8_SA(b, h) (((b) * 2 + (h)) * HTB)
#define PG8_SB(b, h) ((4 + (b) * 2 + (h)) * HTB)
#define PG8_STAGE(bufoff, gbase, voff) do { _Pragma("unroll") for (int _i = 0; _i < 2; ++_i) \
        __builtin_amdgcn_global_load_lds((const unsigned*)((const char*)(gbase) + (voff)[_i]), (LAS unsigned*)(lds + (bufoff) + ldsw + _i * 8192), 16, 0, 0); } while (0)
#define PG8_LDA(dst, b, h) do { _Pragma("unroll") for (int m = 0; m < 4; ++m) _Pragma("unroll") for (int k = 0; k < 2; ++k) dst[m][k] = *(const LAS bf16x8*)(lds + PG8_SA(b, h) + aoff + m * 2048 + k * 1024); } while (0)
#define PG8_LDB(dst, b, h) do { _Pragma("unroll") for (int n = 0; n < 2; ++n) _Pragma("unroll") for (int k = 0; k < 2; ++k) dst[n][k] = *(const LAS bf16x8*)(lds + PG8_SB(b, h) + boff + n * 2048 + k * 1024); } while (0)
#define PG8_MMA(ai, bj, At, Bt) do { __builtin_amdgcn_s_setprio(1); _Pragma("unroll") for (int m = 0; m < 4; ++m) _Pragma("unroll") for (int n = 0; n < 2; ++n) _Pragma("unroll") for (int k = 0; k < 2; ++k) \
        acc[ai][bj][m][n] = __builtin_amdgcn_mfma_f32_16x16x32_bf16(Bt[n][k], At[m][k], acc[ai][bj][m][n], 0, 0, 0); __builtin_amdgcn_s_setprio(0); } while (0)
#define PG8_WAIT_V(n) asm volatile("s_waitcnt vmcnt(" #n ")" ::: "memory")
#define PG8_WAIT_L(n) asm volatile("s_waitcnt lgkmcnt(" #n ")" ::: "memory")
#define PG8_BAR __builtin_amdgcn_s_barrier()
#define PG8_SCHED __builtin_amdgcn_sched_barrier(0)
    Unit cur, nxt; int ui = 0;
    if (!S.next(0, cur)) return;
    f32x4 acc[2][2][4][2];
#pragma unroll
    for (int a = 0; a < 2; ++a)
#pragma unroll
        for (int b = 0; b < 2; ++b)
#pragma unroll
            for (int m = 0; m < 4; ++m)
#pragma unroll
                for (int n = 0; n < 2; ++n) acc[a][b][m][n] = (f32x4){0.f, 0.f, 0.f, 0.f};
    bf16x8 At[4][2], B0[2][2], B1[2][2];
    const char* cA = (const char*)g.A + (size_t)cur.pm * tstep; const char* cB = (const char*)g.Bt + (size_t)cur.pn * tstep;
    S.a_ready(cur);
    if constexpr (SP2) {
        PG8_STAGE(PG8_SB(0, 0), cB, voffB); PG8_STAGE(PG8_SB(0, 1), cB + hstep, voffB); PG8_STAGE(PG8_SA(0, 0), cA, voffA); PG8_STAGE(PG8_SA(0, 1), cA + hstep, voffA);
        if (wr == 1) PG8_BAR;
        PG8_WAIT_V(2); PG8_BAR;
        PG8_STAGE(PG8_SB(1, 0), cB + kstep, voffB); PG8_STAGE(PG8_SA(1, 0), cA + kstep, voffA); PG8_STAGE(PG8_SB(1, 1), cB + hstep + kstep, voffB);
        PG8_WAIT_V(6); PG8_BAR;
    } else {
        PG8_STAGE(PG8_SB(0, 0), cB, voffB); PG8_STAGE(PG8_SA(0, 0), cA, voffA); PG8_STAGE(PG8_SB(0, 1), cB + hstep, voffB); PG8_STAGE(PG8_SA(0, 1), cA + hstep, voffA);
        if (wr == 1) PG8_BAR;
        PG8_WAIT_V(4); PG8_BAR;
        PG8_STAGE(PG8_SB(1, 0), cB + kstep, voffB); PG8_STAGE(PG8_SA(1, 0), cA + kstep, voffA); PG8_STAGE(PG8_SB(1, 1), cB + hstep + kstep, voffB);
        PG8_WAIT_V(6); PG8_BAR;
    }
    for (;;) {
        const bool has_next = S.next(ui + 1, nxt);
        const char* nA = has_next ? (const char*)g.A + (size_t)nxt.pm * tstep : cA; const char* nB = has_next ? (const char*)g.Bt + (size_t)nxt.pn * tstep : cB;
        for (int t = 0; t < nt; t += 2) {
            const bool last = (t == nt - 2);
            const char* a1 = cA + (size_t)(t + 1) * kstep;
            const char* a2 = last ? nA : cA + (size_t)(t + 2) * kstep; const char* b2 = last ? nB : cB + (size_t)(t + 2) * kstep;
            const char* a3 = a2 + kstep; const char* b3 = b2 + kstep;
            if (last && has_next) S.a_ready(nxt);
            if constexpr (Epi::MIDK) { if (t == nt / 2) E.mid(acc, cur, wr, wc, fr, fq); }
            if constexpr (SP2) {
            PG8_LDB(B0, 0, 0); PG8_LDB(B1, 0, 1); PG8_SCHED; PG8_LDA(At, 0, 0); PG8_STAGE(PG8_SA(1, 1), a1 + hstep, voffA);
            PG8_WAIT_V(8); PG8_WAIT_L(0); PG8_BAR; PG8_MMA(0, 0, At, B0); PG8_MMA(0, 1, At, B1); PG8_BAR; PG8_SCHED;
            PG8_LDA(At, 0, 1); PG8_STAGE(PG8_SB(0, 0), b2, voffB); PG8_STAGE(PG8_SB(0, 1), b2 + hstep, voffB); PG8_STAGE(PG8_SA(0, 0), a2, voffA);
            PG8_WAIT_V(8); PG8_WAIT_L(0); PG8_BAR; PG8_MMA(1, 0, At, B0); PG8_MMA(1, 1, At, B1); PG8_BAR; PG8_SCHED;
            PG8_LDB(B0, 1, 0); PG8_LDB(B1, 1, 1); PG8_SCHED; PG8_LDA(At, 1, 0); PG8_STAGE(PG8_SA(0, 1), a2 + hstep, voffA);
            PG8_WAIT_V(8); PG8_WAIT_L(0); PG8_BAR; PG8_MMA(0, 0, At, B0); PG8_MMA(0, 1, At, B1); PG8_BAR; PG8_SCHED;
            PG8_LDA(At, 1, 1); PG8_STAGE(PG8_SB(1, 0), b3, voffB); PG8_STAGE(PG8_SB(1, 1), b3 + hstep, voffB); PG8_STAGE(PG8_SA(1, 0), a3, voffA);
            PG8_WAIT_V(8); PG8_WAIT_L(0); PG8_BAR; PG8_MMA(1, 0, At, B0); PG8_MMA(1, 1, At, B1); PG8_BAR; PG8_SCHED;
            } else {
            PG8_LDB(B0, 0, 0); PG8_SCHED; PG8_LDA(At, 0, 0); PG8_STAGE(PG8_SA(1, 1), a1 + hstep, voffA);
            PG8_WAIT_L(8); PG8_BAR; PG8_WAIT_L(0); PG8_MMA(0, 0, At, B0); PG8_BAR; PG8_SCHED;
            PG8_LDB(B1, 0, 1); PG8_STAGE(PG8_SB(0, 0), b2, voffB);
            PG8_BAR; PG8_WAIT_L(0); PG8_MMA(0, 1, At, B1); PG8_BAR;
            PG8_LDA(At, 0, 1); PG8_STAGE(PG8_SA(0, 0), a2, voffA);
            PG8_BAR; PG8_WAIT_L(0); PG8_MMA(1, 0, At, B0); PG8_BAR; PG8_SCHED;
            PG8_STAGE(PG8_SB(0, 1), b2 + hstep, voffB);
            PG8_WAIT_V(6); PG8_BAR; PG8_MMA(1, 1, At, B1); PG8_BAR;
            PG8_LDB(B0, 1, 0); PG8_SCHED; PG8_LDA(At, 1, 0); PG8_STAGE(PG8_SA(0, 1), a2 + hstep, voffA);
            PG8_WAIT_L(8); PG8_BAR; PG8_WAIT_L(0); PG8_MMA(0, 0, At, B0); PG8_BAR; PG8_SCHED;
            PG8_LDB(B1, 1, 1); PG8_STAGE(PG8_SB(1, 0), b3, voffB);
            PG8_BAR; PG8_WAIT_L(0); PG8_MMA(0, 1, At, B1); PG8_BAR;
            PG8_LDA(At, 1, 1); PG8_STAGE(PG8_SA(1, 0), a3, voffA);
            PG8_BAR; PG8_WAIT_L(0); PG8_MMA(1, 0, At, B0); PG8_BAR; PG8_SCHED;
            PG8_STAGE(PG8_SB(1, 1), b3 + hstep, voffB);
            PG8_WAIT_V(6); PG8_BAR; PG8_MMA(1, 1, At, B1); PG8_BAR;
            }
        }
        if constexpr (ALIGN_EPI) { if (wr == 0) PG8_BAR; }
        E(acc, cur, wr, wc, fr, fq); S.done(cur);
        if (!has_next) break;
#pragma unroll
        for (int a = 0; a < 2; ++a)
#pragma unroll
            for (int b = 0; b < 2; ++b)
#pragma unroll
                for (int m = 0; m < 4; ++m)
#pragma unroll
                    for (int n = 0; n < 2; ++n) acc[a][b][m][n] = (f32x4){0.f, 0.f, 0.f, 0.f};
        cur = nxt; cA = nA; cB = nB; ++ui;
        if constexpr (ALIGN_EPI) { if (wr == 1) PG8_BAR; }
    }
    PG8_WAIT_V(0);
    if constexpr (!ALIGN_EPI) { if (wr == 0) PG8_BAR; }
    PG8_BAR;
#undef PG8_SA
#undef PG8_SB
#undef PG8_STAGE
#undef PG8_LDA
#undef PG8_LDB
#undef PG8_MMA
#undef PG8_WAIT_V
#undef PG8_WAIT_L
#undef PG8_BAR
#undef PG8_SCHED
}
}

template <int MODE>
__device__ __forceinline__ void mini_gemm(LAS unsigned char* lds, const bf16* A, const bf16* Bt, int unit, int wave, int lane, int tid, const bf16* msig_s, bf16* mrg_s, const float* xs, float* ys) {
    const int r0 = (unit >> 6) * 64, c0 = (unit & 63) * 32;
    const int m = lane & 15, kq = lane >> 4;
    const bf16* ap = A + (size_t)(r0 + m) * 2048 + wave * 256 + 8 * kq;
    const bf16* bp = Bt + (size_t)(c0 + m) * 2048 + wave * 256 + 8 * kq;
    f32x4 acc[4][2];
#pragma unroll
    for (int i = 0; i < 4; ++i) { acc[i][0] = (f32x4){0.f, 0.f, 0.f, 0.f}; acc[i][1] = acc[i][0]; }
    bf16x8 fa[4][4], fb[4][2];
    const bf16* ap1 = ap + 16 * 2048; const bf16* ap2 = ap + 32 * 2048; const bf16* ap3 = ap + 48 * 2048; const bf16* bp1 = bp + 16 * 2048;
#define MG_LD(dst_, ptr_, st_) asm volatile("global_load_dwordx4 %0, %1, off offset:%2" : "=&v"(dst_) : "v"(ptr_), "n"(64 * (st_)) : "memory")
#define MG_LOAD(st_) do { MG_LD(fa[(st_) & 3][0], ap, st_); MG_LD(fa[(st_) & 3][1], ap1, st_); MG_LD(fa[(st_) & 3][2], ap2, st_); MG_LD(fa[(st_) & 3][3], ap3, st_); \
                          MG_LD(fb[(st_) & 3][0], bp, st_); MG_LD(fb[(st_) & 3][1], bp1, st_); } while (0)
    const int rl = tid >> 3, cl = (tid & 7) * 4, row = r0 + rl, col = c0 + cl;
    u32x2 gs, gf; f32x4 xin;
    if (MODE == 0) { gs = *(const u32x2*)(msig_s + (size_t)row * 4096 + col); gf = *(const u32x2*)(msig_s + (size_t)row * 4096 + 2048 + col); }
    else xin = *(const f32x4*)(xs + (size_t)row * 2048 + col);
    __builtin_amdgcn_sched_barrier(0);
    MG_LOAD(0); MG_LOAD(1); MG_LOAD(2); MG_LOAD(3);
#pragma unroll
    for (int st = 0; st < 8; ++st) {
        __builtin_amdgcn_sched_barrier(0);
        if (st <= 4) asm volatile("s_waitcnt vmcnt(18)" ::: "memory"); else if (st == 5) asm volatile("s_waitcnt vmcnt(12)" ::: "memory");
        else if (st == 6) asm volatile("s_waitcnt vmcnt(6)" ::: "memory"); else asm volatile("s_waitcnt vmcnt(0)" ::: "memory");
        __builtin_amdgcn_sched_barrier(0);
#pragma unroll
        for (int i = 0; i < 4; ++i)
#pragma unroll
            for (int j = 0; j < 2; ++j) acc[i][j] = __builtin_amdgcn_mfma_f32_16x16x32_bf16(fb[st & 3][j], fa[st & 3][i], acc[i][j], 0, 0, 0);
        __builtin_amdgcn_sched_barrier(0);
        if (st + 4 < 8) MG_LOAD(st + 4);
    }
#undef MG_LOAD
#undef MG_LD
    LAS float* part = (LAS float*)lds + wave * 2048;
#pragma unroll
    for (int i = 0; i < 4; ++i)
#pragma unroll
        for (int j = 0; j < 2; ++j) *(LAS f32x4*)(part + (16 * i + m) * 32 + 16 * j + 4 * kq) = acc[i][j];
    LDS_WAIT(); __syncthreads();
    {
        const LAS float* pp = (const LAS float*)lds + rl * 32 + cl;
        f32x4 s1 = *(const LAS f32x4*)pp + *(const LAS f32x4*)(pp + 2048) + *(const LAS f32x4*)(pp + 4096) + *(const LAS f32x4*)(pp + 6144);
        f32x4 s2 = *(const LAS f32x4*)(pp + 8192) + *(const LAS f32x4*)(pp + 10240) + *(const LAS f32x4*)(pp + 12288) + *(const LAS f32x4*)(pp + 14336);
        if (MODE == 0) {
            u32x2 w; w.x = cvt_pk_bf16(s1[0] * bf_lo(gs.x) + s2[0] * bf_lo(gf.x), s1[1] * bf_hi(gs.x) + s2[1] * bf_hi(gf.x));
            w.y = cvt_pk_bf16(s1[2] * bf_lo(gs.y) + s2[2] * bf_lo(gf.y), s1[3] * bf_hi(gs.y) + s2[3] * bf_hi(gf.y));
            *(u32x2*)(mrg_s + (size_t)row * 2048 + col) = w;
        } else {
            *(f32x4*)(ys + (size_t)row * 2048 + col) = s1 + s2 + xin;
        }
    }
    LDS_WAIT(); __syncthreads();
}

#define XB_TMO      128
#define XB_XCNT(j)  (256  + 64 * (j))
#define XB_XSUB(j)  (1280 + 64 * (j))
#define XB_XGEN(j)  (2304 + 64 * (j))
#define XB_TOP      3328
#define XB_TOPGEN   3392
#define XCD_BAR_WORDS 3456
#define XB_SPIN_CAP (1u << 18)
__device__ __forceinline__ unsigned xb_ld(unsigned* p)              { return __hip_atomic_load(p, __ATOMIC_RELAXED, __HIP_MEMORY_SCOPE_AGENT); }
__device__ __forceinline__ unsigned xb_add(unsigned* p, unsigned v) { return __hip_atomic_fetch_add(p, v, __ATOMIC_RELAXED, __HIP_MEMORY_SCOPE_AGENT); }
__device__ __forceinline__ unsigned xb_xcc_id() { return (unsigned)__builtin_amdgcn_s_getreg((3 << 11) | 20) & 0xFu; }
#define XB_SPIN(cond, bar) do { unsigned _sp = 0; while (cond) { __builtin_amdgcn_s_sleep(1); \
    if ((++_sp & 255u) == 0u) { if (xb_ld(&(bar)[XB_TMO])) break; if (_sp > XB_SPIN_CAP) { atomicAdd(&(bar)[XB_TMO], 1u); break; } } } } while (0)
struct XcdBarrier { unsigned* bar; unsigned x; volatile LAS unsigned* st; int wave; };
__device__ __forceinline__ XcdBarrier xcd_barrier_post(unsigned* bar, volatile LAS unsigned* st, int wave) {
    XcdBarrier b; b.bar = bar; b.x = xb_xcc_id(); b.st = st; b.wave = wave;
    if (wave == 0 && lane_id() == 0) (void)xb_add(&bar[XB_XCNT(b.x)], 1u);
    return b;
}
__device__ __forceinline__ void xcd_barrier_complete(unsigned* bar, unsigned x, unsigned& nloc, unsigned& nx) {
    const unsigned G = gridDim.x * gridDim.y * gridDim.z;
    unsigned sum, cnt, mine, sp = 0u;
    for (;;) {
        sum = 0u; cnt = 0u; mine = 0u;
#pragma unroll
        for (unsigned j = 0; j < 16; ++j) { const unsigned c = xb_ld(&bar[XB_XCNT(j)]); sum += c; cnt += (c > 0u) ? 1u : 0u; mine = (j == x) ? c : mine; }
        if (sum == G) break;
        __builtin_amdgcn_s_sleep(1);
        if ((++sp & 255u) == 0u) { if (xb_ld(&bar[XB_TMO])) break; if (sp > XB_SPIN_CAP) { atomicAdd(&bar[XB_TMO], 1u); break; } }
    }
    nloc = mine > 0u ? mine : 1u; nx = cnt > 0u ? cnt : 1u;
}
__device__ __forceinline__ void xcd_barrier(const XcdBarrier& b) {
    asm volatile("s_waitcnt vmcnt(0)" ::: "memory");
    __syncthreads();
    if (b.wave == 0 && lane_id() == 0) {
        unsigned* bar = b.bar;
        __builtin_amdgcn_s_waitcnt(0);
        unsigned nloc = b.st[0], nx = b.st[1];
        if (nloc == 0u) { xcd_barrier_complete(bar, b.x, nloc, nx); b.st[0] = nloc; b.st[1] = nx; }
        const unsigned old = xb_add(&bar[XB_XSUB(b.x)], 1u);
        const unsigned gen = old / nloc;
        if (old + 1u == (gen + 1u) * nloc) {
            __builtin_amdgcn_fence(__ATOMIC_RELEASE, "agent");
            asm volatile("s_waitcnt vmcnt(0)" ::: "memory");
            const unsigned og = xb_add(&bar[XB_TOP], 1u);
            const unsigned tg = og / nx;
            if (og + 1u == (tg + 1u) * nx) xb_add(&bar[XB_TOPGEN], 1u);
            else XB_SPIN(xb_ld(&bar[XB_TOPGEN]) == tg, bar);
            __builtin_amdgcn_fence(__ATOMIC_ACQUIRE, "agent");
            xb_add(&bar[XB_XGEN(b.x)], 1u);
            asm volatile("s_waitcnt vmcnt(0)" ::: "memory");
        } else {
            XB_SPIN(xb_ld(&bar[XB_XGEN(b.x)]) == gen, bar);
            __builtin_amdgcn_fence(__ATOMIC_ACQUIRE, "agent");
            asm volatile("s_waitcnt vmcnt(0)" ::: "memory");
        }
    }
    __syncthreads();
}

__device__ __forceinline__ float wave_sum(float v) {
#pragma unroll
    for (int o = 1; o < 64; o <<= 1) v += __shfl_xor(v, o);
    return v;
}
__device__ __forceinline__ void p0_transpose_item(const float* W, int ld, int nblk, bf16* WT, int ldt, LAS float* scr, int item, int lane) {
    const int kb = item / nblk, nb = item % nblk, k0 = 64 * kb, n0 = 32 * nb;
#pragma unroll 8
    for (int i = 0; i < 32; ++i) { const int kk = 2 * i + (lane >> 5); scr[kk * 33 + (lane & 31)] = __builtin_nontemporal_load(W + (size_t)(k0 + kk) * ld + n0 + (lane & 31)); }
    LDS_WAIT(); asm volatile("" ::: "memory");
    const int c = lane & 7;
#pragma unroll
    for (int j = 0; j < 4; ++j) { const int n = (lane >> 3) + 8 * j; const LAS float* s = scr + (8 * c) * 33 + n;
        u32x4 o; o.x = cvt_pk_bf16(s[0 * 33], s[1 * 33]); o.y = cvt_pk_bf16(s[2 * 33], s[3 * 33]); o.z = cvt_pk_bf16(s[4 * 33], s[5 * 33]); o.w = cvt_pk_bf16(s[6 * 33], s[7 * 33]);
        *(u32x4*)(WT + (size_t)(n0 + n) * ldt + k0 + 8 * c) = o; }
    LDS_WAIT(); asm volatile("" ::: "memory");
}

struct Ptrs {
    const float *xp, *xs, *csbk, *csbv, *cfxk, *cfxv, *cflf, *normw, *win, *bfor, *qnw, *knw, *wbsb, *wbfx, *wout;
    float* out; unsigned char* ws;
};

__device__ __forceinline__ void p0_prologue(const Ptrs& P, LAS unsigned char* lds, int gw, int NGW, int wave, int lane, int tid) {
    LAS float* wfT = (LAS float*)(lds + 69632);
    for (int i = tid; i < 2048 * 2; i += 512) { const int k = i >> 1, hf = i & 1; const f32x4 v = *(const f32x4*)(P.win + (size_t)k * DIN + 8192 + 4 * hf);
#pragma unroll
        for (int j = 0; j < 4; ++j) wfT[(4 * hf + j) * 2048 + k] = v[j]; }
    LAS float* scr = (LAS float*)(lds + wave * 8448);
    constexpr int I_A = 32 * 256, I_B = 32 * 128, NITEMS = I_A + I_B;
    bf16* Wt = (bf16*)(P.ws + WS_WIN);
    for (int it = gw; it < NITEMS; it += NGW) {
        int r = it;
        if (r < I_A) { p0_transpose_item(P.win, DIN, 256, Wt, 2048, scr, r, lane); continue; } r -= I_A;
        p0_transpose_item(P.win + 8200, DIN, 128, Wt + (size_t)8192 * 2048, 2048, scr, r, lane);
    }
    __syncthreads();
    f32x4 nw[8];
#pragma unroll
    for (int i = 0; i < 8; ++i) nw[i] = *(const f32x4*)(P.normw + 4 * lane + 256 * i);
    bf16* H = (bf16*)(P.ws + WS_H);
    for (int m = gw; m < TT; m += NGW) {
        const float* xr = (m < TP) ? P.xp + (size_t)m * DM : P.xs + (size_t)(m - TP) * DM;
        f32x4 v[8]; float ss = 0.f;
#pragma unroll
        for (int i = 0; i < 8; ++i) { v[i] = __builtin_nontemporal_load((const f32x4*)(xr + 4 * lane + 256 * i)); ss += (v[i][0] * v[i][0] + v[i][1] * v[i][1]) + (v[i][2] * v[i][2] + v[i][3] * v[i][3]); }
        const float rstd = 1.0f / sqrtf(wave_sum(ss) * (1.0f / DM) + RMS_EPS);
        unsigned long long* o8 = (unsigned long long*)(H + (size_t)m * DM) + lane;
        float fl[8] = {0.f, 0.f, 0.f, 0.f, 0.f, 0.f, 0.f, 0.f};
#pragma unroll
        for (int i = 0; i < 8; ++i) { v[i] = v[i] * rstd * nw[i];
            o8[64 * i] = (unsigned long long)cvt_pk_bf16(v[i][0], v[i][1]) | ((unsigned long long)cvt_pk_bf16(v[i][2], v[i][3]) << 32);
#pragma unroll
            for (int j = 0; j < 8; ++j) { const f32x4 w = *(const LAS f32x4*)(wfT + j * 2048 + 4 * lane + 256 * i); fl[j] += (v[i][0] * w[0] + v[i][1] * w[1]) + (v[i][2] * w[2] + v[i][3] * w[3]); } }
        float mine = 0.f;
#pragma unroll
        for (int j = 0; j < 8; ++j) { const float t = wave_sum(fl[j]); mine = (lane == j) ? t : mine; }
        if (lane < 8) { const float z = mine + P.bfor[lane]; const float lf = fminf(z, 0.f) - log1pf(expf(-fabsf(z)));
            float* dst = (m < TP) ? P.out + O_PLF + (size_t)m * 8 : P.out + O_SLF + (size_t)(m - TP) * 8; dst[lane] = lf; }
    }
}

__device__ __forceinline__ void p1_side_weights(const Ptrs& P, LAS unsigned char* lds, int sw, int nsw, int wave, int lane) {
    LAS float* scr = (LAS float*)(lds + wave * 8448);
    constexpr int I_S = 16 * 64, I_O = 32 * 64, NITEMS = 2 * I_S + I_O;
    bf16* Wb = (bf16*)(P.ws + WS_WB); bf16* Wo = (bf16*)(P.ws + WS_WO);
    for (int it = sw; it < NITEMS; it += nsw) {
        int r = it;
        if (r < I_S) { p0_transpose_item(P.wbsb, 2048, 64, Wb, 2048, scr, r, lane); continue; } r -= I_S;
        if (r < I_S) { p0_transpose_item(P.wbfx, 2048, 64, Wb + 1024, 2048, scr, r, lane); continue; } r -= I_S;
        p0_transpose_item(P.wout, 2048, 64, Wo, 2048, scr, r, lane);
    }
}

__device__ __forceinline__ void p1_side_knorm(const Ptrs& P, int sw, int nsw, int lane) {
    const int r32 = lane & 31, hi = lane >> 5;
    float* kmx = (float*)(P.ws + WS_KMX);
    for (int it = sw; it < NBAT * NH * KN_TILES; it += nsw) {
        const int h = it & 7, bt = it >> 3, b = bt / KN_TILES, tix = bt - b * KN_TILES, bh = b * 8 + h;
        const float* src = P.cfxk + ((size_t)(b * PAST + tix * 32 + hi) * NH + h) * HD + r32 * 4;
        float mx = 0.f;
#pragma unroll 1
        for (int half = 0; half < 2; ++half) {
            f32x4 t[8];
#pragma unroll
            for (int i = 0; i < 8; ++i) t[i] = __builtin_nontemporal_load((const f32x4*)(src + (size_t)(half * 8 + i) * 2 * NH * HD));
#pragma unroll
            for (int i = 0; i < 8; ++i) { float s_ = t[i][0] * t[i][0] + t[i][1] * t[i][1] + t[i][2] * t[i][2] + t[i][3] * t[i][3];
#pragma unroll
                for (int o = 1; o < 32; o <<= 1) s_ += __shfl_xor(s_, o);
                mx = fmaxf(mx, s_); }
        }
        mx = fmaxf(mx, __shfl_xor(mx, 32));
        if (lane == 0) kmx[bh * 128 + tix] = mx;
    }
}

__device__ __forceinline__ void scan_seq(const Ptrs& P, LAS unsigned char* lds, int id, int tid) {
    LAS float* sm = (LAS float*)(lds + XCH_OFF);
    const float* s1; int n1, st1; const float* s2; int n2; float* dst;
    if (id < 8) { s1 = P.out + O_PLF + id; n1 = TP; st1 = 8; s2 = s1; n2 = 0; dst = (float*)(P.ws + WS_F2P) + (size_t)id * TP; }
    else { const int b = (id - 8) >> 3, j = (id - 8) & 7; s1 = P.cflf + (size_t)b * PAST * 8 + j; n1 = PAST; st1 = 8; s2 = P.out + O_SLF + (size_t)b * NSEQ * 8 + j; n2 = NSEQ;
        dst = (float*)(P.ws + WS_F2S) + (size_t)(b * 8 + j) * KT; }
    const int n = n1 + n2, CH = (n + 511) / 512;
    float v[16]; float run = 0.f;
#pragma unroll
    for (int i = 0; i < 16; ++i) { const int idx = tid * CH + i; if (i < CH && idx < n) { const float x = idx < n1 ? s1[(size_t)idx * st1] : s2[(size_t)(idx - n1) * 8]; run += x; } v[i] = run; }
    const int lane = tid & 63, wave = tid >> 6;
    float inc = run;
#pragma unroll
    for (int o = 1; o < 64; o <<= 1) { const float t = __shfl_up(inc, o); if (lane >= o) inc += t; }
    if (lane == 63) sm[wave] = inc;
    LDS_WAIT(); __syncthreads();
    float base = inc - run;
    for (int w = 0; w < wave; ++w) base += sm[w];
#pragma unroll
    for (int i = 0; i < 16; ++i) { const int idx = tid * CH + i; if (i < CH && idx < n) dst[idx] = (base + v[i]) * LOG2E; }
    __syncthreads();
}

namespace att {
constexpr int SHM_T = 16384;
#define KSWZ(row, colB) ((row) * 256 + ((colB) ^ (((row) & 7) << 4)))
__device__ __forceinline__ int v_st(int k, int c) { const int kk = (k & ~0xC) | ((k & 4) << 1) | ((k & 8) >> 1); return ((kk >> 3) * 4 + (c >> 5)) * 512 + ((kk & 7) * 32 + (c & 31)) * 2; }
__device__ __forceinline__ int v_rd_base(int lane) { return ((lane & 3) << 3) | (((lane >> 2) & 3) << 6) | (((lane >> 4) & 1) << 5) | (((lane >> 5) & 1) << 8); }
__device__ __forceinline__ int crow(int r, int hi) { return (r & 3) + 8 * (r >> 2) + 4 * hi; }

__device__ __forceinline__ __amdgpu_buffer_rsrc_t mk_rsrc(const void* p, int bytes) {
    const unsigned long long a = (unsigned long long)p;
    const unsigned lo = __builtin_amdgcn_readfirstlane((unsigned)a), hi = __builtin_amdgcn_readfirstlane((unsigned)(a >> 32));
    return __builtin_amdgcn_make_buffer_rsrc((void*)(((unsigned long long)hi << 32) | lo), 0, bytes, 0x00020000);
}
template <int NB>
__device__ __forceinline__ void qkt(f32x16& p0, f32x16& p1, const LAS char* Kb, int r32, int hi, const bf16x8 (&qr)[8]) {
    p0 = (f32x16){0.f, 0.f, 0.f, 0.f, 0.f, 0.f, 0.f, 0.f, 0.f, 0.f, 0.f, 0.f, 0.f, 0.f, 0.f, 0.f}; p1 = p0;
    const LAS char* kb[4];
#pragma unroll
    for (int dd = 0; dd < 4; ++dd) kb[dd] = Kb + KSWZ(r32, (dd * 16 + hi * 8) * 2);
#pragma unroll
    for (int d0 = 0; d0 < 8; ++d0) { const LAS char* a = kb[d0 & 3] + (d0 >> 2) * 128;
        const bf16x8 b0 = *(const LAS bf16x8*)a;
        p0 = __builtin_amdgcn_mfma_f32_32x32x16_bf16(b0, qr[d0], p0, 0, 0, 0);
        if (NB == 2) { const bf16x8 b1 = *(const LAS bf16x8*)(a + 32 * 256); p1 = __builtin_amdgcn_mfma_f32_32x32x16_bf16(b1, qr[d0], p1, 0, 0, 0); } }
}
__device__ __forceinline__ void qkt_qlds(f32x16& p0, const LAS char* Kb, const LAS char* Qb, int r32, int hi, int qrow) {
    p0 = (f32x16){0.f, 0.f, 0.f, 0.f, 0.f, 0.f, 0.f, 0.f, 0.f, 0.f, 0.f, 0.f, 0.f, 0.f, 0.f, 0.f};
    const LAS char* kb[4];
#pragma unroll
    for (int dd = 0; dd < 4; ++dd) kb[dd] = Kb + KSWZ(r32, (dd * 16 + hi * 8) * 2);
    const LAS char* qb = Qb + qrow * 256;
#pragma unroll
    for (int d0 = 0; d0 < 8; ++d0) { const LAS char* a = kb[d0 & 3] + (d0 >> 2) * 128;
        const bf16x8 b0 = *(const LAS bf16x8*)a;
        const bf16x8 q = *(const LAS bf16x8*)(qb + (((d0 * 2 + hi) ^ qrow) << 4));
        p0 = __builtin_amdgcn_mfma_f32_32x32x16_bf16(b0, q, p0, 0, 0, 0); }
}
template <int NB>
__device__ __forceinline__ void pv_tile(f32x16 (&o)[4], int vb0, bf16x8 pa0, bf16x8 pa1, bf16x8 pa2, bf16x8 pa3) {
#define TRRD(dst, off) asm volatile("ds_read_b64_tr_b16 %0, %1 offset:%2" : "=&v"(dst) : "v"(vb0), "i"(off) : "memory")
#define PV_D0(d0) do { s16x4 l0, l1, l2, l3, h0, h1, h2, h3; constexpr int b_ = (d0) * 512;   \
        TRRD(l0, b_); TRRD(h0, b_ + 2048); TRRD(l1, b_ + 4096); TRRD(h1, b_ + 6144);   \
        if (NB == 2) { TRRD(l2, b_ + 8192); TRRD(h2, b_ + 10240); TRRD(l3, b_ + 12288); TRRD(h3, b_ + 14336); }   \
        asm volatile("s_waitcnt lgkmcnt(0)" ::: "memory"); __builtin_amdgcn_sched_barrier(0);   \
        o[d0] = __builtin_amdgcn_mfma_f32_32x32x16_bf16(pa0, (bf16x8){l0[0], l0[1], l0[2], l0[3], h0[0], h0[1], h0[2], h0[3]}, o[d0], 0, 0, 0);   \
        o[d0] = __builtin_amdgcn_mfma_f32_32x32x16_bf16(pa1, (bf16x8){l1[0], l1[1], l1[2], l1[3], h1[0], h1[1], h1[2], h1[3]}, o[d0], 0, 0, 0);   \
        if (NB == 2) {   \
        o[d0] = __builtin_amdgcn_mfma_f32_32x32x16_bf16(pa2, (bf16x8){l2[0], l2[1], l2[2], l2[3], h2[0], h2[1], h2[2], h2[3]}, o[d0], 0, 0, 0);   \
        o[d0] = __builtin_amdgcn_mfma_f32_32x32x16_bf16(pa3, (bf16x8){l3[0], l3[1], l3[2], l3[3], h3[0], h3[1], h3[2], h3[3]}, o[d0], 0, 0, 0); } } while (0)
    PV_D0(0); PV_D0(1); PV_D0(2); PV_D0(3);
#undef PV_D0
#undef TRRD
}
#define PK4(P, B_, OUT) do { unsigned a0 = cvt_pk_bf16(P[B_+0], P[B_+1]), a1 = cvt_pk_bf16(P[B_+2], P[B_+3]);   \
        unsigned b0 = cvt_pk_bf16(P[B_+4], P[B_+5]), b1 = cvt_pk_bf16(P[B_+6], P[B_+7]);   \
        auto r0 = __builtin_amdgcn_permlane32_swap(a0, b0, false, false); auto r1 = __builtin_amdgcn_permlane32_swap(a1, b1, false, false);   \
        u32x4 w = {r0[0], r1[0], r0[1], r1[1]}; OUT = __builtin_bit_cast(bf16x8, w); } while (0)

__device__ __forceinline__ void xchg32(float v, float& x0, float& x1) {
    const unsigned a = __builtin_bit_cast(unsigned, v);
    auto rr = __builtin_amdgcn_permlane32_swap(a, a, false, false);
    const unsigned r0 = rr[0], r1 = rr[1];
    x0 = __builtin_bit_cast(float, r0); x1 = __builtin_bit_cast(float, r1);
}
template <int NB, bool MASK>
__device__ __forceinline__ float sb_step_a(f32x16& p0, f32x16& p1, int dq, int hi, float (&PS)[8], float (&GS)[8]) {
#pragma unroll
    for (int r = 0; r < 16; ++r) {
        const int c = (r & 3) + 8 * (r >> 2);
        float a = __builtin_amdgcn_rcpf(1.0f + __builtin_amdgcn_exp2f(p0[r])); if (MASK) a = (c < dq) ? a : 1.0f; p0[r] = a;
        if (NB == 2) { float b = __builtin_amdgcn_rcpf(1.0f + __builtin_amdgcn_exp2f(p1[r])); if (MASK) b = (c + 32 < dq) ? b : 1.0f; p1[r] = b; }
    }
    float tot = 1.0f;
#pragma unroll
    for (int g = 0; g < 4 * NB; ++g) {
        const int r = 4 * (g & 3);
        const float G = (g < 4) ? (p0[r] * p0[r + 1]) * (p0[r + 2] * p0[r + 3]) : (p1[r] * p1[r + 1]) * (p1[r + 2] * p1[r + 3]);
        float x0, x1; xchg32(G, x0, x1);
        PS[g] = x0 * x1; GS[g] = hi ? 1.0f : x1; tot *= PS[g];
    }
    return tot;
}
template <int NB>
__device__ __forceinline__ void sb_step_b(f32x16& p0, f32x16& p1, float C, const float (&PS)[8], const float (&GS)[8], bf16x8& pa0, bf16x8& pa1, bf16x8& pa2, bf16x8& pa3) {
    float X = C;
#pragma unroll
    for (int g = 4 * NB - 1; g >= 0; --g) {
        const int r = 4 * (g & 3);
        const float E = X * GS[g];
        if (g < 4) { const float a0 = p0[r], a1 = p0[r + 1], a2 = p0[r + 2], a3 = p0[r + 3]; const float P3 = E, P2 = P3 * a3, P1 = P2 * a2, P0 = P1 * a1;
            p0[r + 3] = __builtin_fmaf(-P3, a3, P3); p0[r + 2] = __builtin_fmaf(-P2, a2, P2); p0[r + 1] = __builtin_fmaf(-P1, a1, P1); p0[r] = __builtin_fmaf(-P0, a0, P0); }
        else { const float a0 = p1[r], a1 = p1[r + 1], a2 = p1[r + 2], a3 = p1[r + 3]; const float P3 = E, P2 = P3 * a3, P1 = P2 * a2, P0 = P1 * a1;
            p1[r + 3] = __builtin_fmaf(-P3, a3, P3); p1[r + 2] = __builtin_fmaf(-P2, a2, P2); p1[r + 1] = __builtin_fmaf(-P1, a1, P1); p1[r] = __builtin_fmaf(-P0, a0, P0); }
        X *= PS[g];
    }
    PK4(p0, 0, pa0); PK4(p0, 8, pa1);
    if (NB == 2) { PK4(p1, 0, pa2); PK4(p1, 8, pa3); }
}
template <int NB, bool MASK, class FPtr>
__device__ __forceinline__ float fox_weights(f32x16& p0, f32x16& p1, FPtr F2k, int dq, float& m, float& l, float& alpha, bf16x8& pa0, bf16x8& pa1, bf16x8& pa2, bf16x8& pa3) {
    const float NEG = -__builtin_inff();
    float mx = NEG;
#pragma unroll
    for (int g = 0; g < 4; ++g) {
        const f32x4 f0 = F2k[2 * g];
#pragma unroll
        for (int i = 0; i < 4; ++i) { float x = p0[4 * g + i] - f0[i]; if (MASK) x = (i + 8 * g <= dq) ? x : NEG; p0[4 * g + i] = x; mx = fmaxf(mx, x); }
        if (NB == 2) { const f32x4 f1 = F2k[8 + 2 * g];
#pragma unroll
            for (int i = 0; i < 4; ++i) { float x = p1[4 * g + i] - f1[i]; if (MASK) x = (i + 8 * g + 32 <= dq) ? x : NEG; p1[4 * g + i] = x; mx = fmaxf(mx, x); } }
    }
    { float x0, x1; xchg32(mx, x0, x1); mx = fmaxf(x0, x1); }
    const float mn = fmaxf(m, mx);
    alpha = __builtin_amdgcn_exp2f(m - mn); m = mn;
    float ps = 0.f;
#pragma unroll
    for (int r = 0; r < 16; ++r) { p0[r] = __builtin_amdgcn_exp2f(p0[r] - mn); ps += p0[r]; if (NB == 2) { p1[r] = __builtin_amdgcn_exp2f(p1[r] - mn); ps += p1[r]; } }
    { float x0, x1; xchg32(ps, x0, x1); ps = x0 + x1; }
    l = l * alpha + ps;
    PK4(p0, 0, pa0); PK4(p0, 8, pa1);
    if (NB == 2) { PK4(p1, 0, pa2); PK4(p1, 8, pa3); }
    return ps;
}

__device__ __forceinline__ void qk_half(f32x16& p, const LAS char* Kb, int r32, int hi, const LAS char* qx, int rx) {
    p = (f32x16){0.f, 0.f, 0.f, 0.f, 0.f, 0.f, 0.f, 0.f, 0.f, 0.f, 0.f, 0.f, 0.f, 0.f, 0.f, 0.f};
    const LAS char* kb[4];
#pragma unroll
    for (int dd = 0; dd < 4; ++dd) kb[dd] = Kb + KSWZ(r32, (dd * 16 + hi * 8) * 2);
#pragma unroll
    for (int d0 = 0; d0 < 8; ++d0) { const bf16x8 b0 = *(const LAS bf16x8*)(kb[d0 & 3] + (d0 >> 2) * 128);
        const bf16x8 q = *(const LAS bf16x8*)(qx + (((d0 * 2 + hi) ^ rx) << 4));
        p = __builtin_amdgcn_mfma_f32_32x32x16_bf16(b0, q, p, 0, 0, 0);
        if (d0 < 7) __builtin_amdgcn_sched_barrier(0x0011); }
}
template <bool UP>
__device__ __forceinline__ void pv_half(f32x16 (&o)[4], int vb0, bf16x8 pa0, bf16x8 pa1) {
#define TRRD(dst, off) asm volatile("ds_read_b64_tr_b16 %0, %1 offset:%2" : "=&v"(dst) : "v"(vb0), "i"(off) : "memory")
#define PV_D0(d0) do { s16x4 l0, l1, h0, h1; constexpr int b_ = (d0) * 512 + (UP ? 8192 : 0);   \
        TRRD(l0, b_); TRRD(h0, b_ + 2048); TRRD(l1, b_ + 4096); TRRD(h1, b_ + 6144);   \
        asm volatile("s_waitcnt lgkmcnt(0)" ::: "memory"); __builtin_amdgcn_sched_barrier(0);   \
        o[d0] = __builtin_amdgcn_mfma_f32_32x32x16_bf16(pa0, (bf16x8){l0[0], l0[1], l0[2], l0[3], h0[0], h0[1], h0[2], h0[3]}, o[d0], 0, 0, 0);   \
        o[d0] = __builtin_amdgcn_mfma_f32_32x32x16_bf16(pa1, (bf16x8){l1[0], l1[1], l1[2], l1[3], h1[0], h1[1], h1[2], h1[3]}, o[d0], 0, 0, 0); } while (0)
    PV_D0(0); PV_D0(1); PV_D0(2); PV_D0(3);
#undef PV_D0
#undef TRRD
}

template <int MODE>
__device__ __forceinline__ void prompt_block(LAS char* lds, const bf16* Qh, const bf16* Kh, const bf16* Vh, const float* F2h, const bf16* Gh, bf16* Ah, int qb, float zb, int wave_) {
    int tid_ = wave_ * 64 + lane_id(); asm volatile("" : "+v"(tid_));
    const int tid = tid_, wid = __builtin_amdgcn_readfirstlane(tid >> 6), lane = tid & 63, r32 = lane & 31, hi = lane >> 5;
    const int P0 = qb * 256, qlo = P0 + wid * 32, trow = qlo + r32;
    LAS char* Vl = lds; LAS char* Kl = lds + 2 * SHM_T;
    LAS float* wsm = (LAS float*)(lds + 5 * SHM_T) + wid * 64; LAS int* flg = (LAS int*)(lds + 5 * SHM_T + 2048);
    LAS float* fbuf = (LAS float*)(lds + 5 * SHM_T + 4096);
    LAS char* Qw = lds + 5 * SHM_T + 8192 + wid * 8192;
#pragma unroll
    for (int i = 0; i < 8; ++i) { const int idx = lane + 64 * i, r = idx >> 4, c = idx & 15;
        *(LAS bf16x8*)(Qw + r * 256 + ((c ^ (r & 15)) << 4)) = *(const bf16x8*)(Qh + (size_t)(qlo + r) * 128 + c * 8); }
    const LAS char* qx = Qw + r32 * 256; const int rx = r32 & 15;
    const int NT = 4 * qb + 4;
    const int sr = tid >> 4, sc = (tid & 15) * 8;
    const int kws = KSWZ(sr, sc * 2), vst0 = v_st(sr, sc), vst1 = v_st(32 + sr, sc);
    const int vrb = (int)(unsigned)(size_t)Vl + v_rd_base(lane);
    bf16x8 sk0, sk1, sv0, sv1; float sf = 0.f;
#define PB_KB(it_) ((NT - 1 - (it_)) * 64)
#define PB_ACT(hk_) ((MODE == 0) ? ((hk_) <= qlo + 30) : ((hk_) <= qlo + 31))
#define PB_NM(hk_) ((MODE == 0) ? ((hk_) + 31 >= qlo) : ((hk_) + 31 > qlo))
    const __amdgpu_buffer_rsrc_t rK = mk_rsrc(Kh, TT * 256), rV = mk_rsrc(Vh, TT * 256);
    const int svo = sr * 256 + sc * 2;
#define PB_LOADK(it_) do { const int so_ = PB_KB(it_) * 256; sk0 = __builtin_bit_cast(bf16x8, __builtin_amdgcn_raw_buffer_load_b128(rK, svo, so_, 0)); sk1 = __builtin_bit_cast(bf16x8, __builtin_amdgcn_raw_buffer_load_b128(rK, svo, so_ + 8192, 0)); } while (0)
#define PB_LOADV(it_) do { const int so_ = PB_KB(it_) * 256; sv0 = __builtin_bit_cast(bf16x8, __builtin_amdgcn_raw_buffer_load_b128(rV, svo, so_, 0)); sv1 = __builtin_bit_cast(bf16x8, __builtin_amdgcn_raw_buffer_load_b128(rV, svo, so_ + 8192, 0)); \
        if (MODE == 1 && tid < 64) sf = F2h[PB_KB(it_) + tid]; } while (0)
#define PB_WRITEK(ko_) do { *(LAS bf16x8*)(Kl + (ko_) + kws) = sk0; *(LAS bf16x8*)(Kl + (ko_) + kws + 32 * 256) = sk1; } while (0)
#define PB_WRITEV(bf) do { *(LAS bf16x8*)(Vl + (bf) * SHM_T + vst0) = sv0; *(LAS bf16x8*)(Vl + (bf) * SHM_T + vst1) = sv1; \
        if (MODE == 1 && tid < 64) fbuf[(bf) * 64 + tid] = sf; } while (0)
    PB_LOADK(0); PB_LOADV(0); PB_WRITEK(0); PB_WRITEV(0);
    if (NT > 1) { PB_LOADK(1); PB_WRITEK(SHM_T); }
    LDS_WAIT(); __syncthreads();
    f32x16 o[4];
#pragma unroll
    for (int d = 0; d < 4; ++d) o[d] = (f32x16){0.f, 0.f, 0.f, 0.f, 0.f, 0.f, 0.f, 0.f, 0.f, 0.f, 0.f, 0.f, 0.f, 0.f, 0.f, 0.f};
    float C = 1.0f, m_run = -1e30f, l_run = 0.f;
    f32x16 pA, pB, pdum;
    if (PB_ACT(PB_KB(0) + 32)) qk_half(pA, Kl + 32 * 256, r32, hi, qx, rx);
#define PB_WEIGHTS(MASK_, PC, dq_, fk_) do {                                                                                      \
        if (MODE == 0) { float PS[8], GS[8]; const float tot = sb_step_a<1, MASK_>(PC, pdum, dq_, hi, PS, GS);                      \
            sb_step_b<1>(PC, pdum, C, PS, GS, pa0, pa1, pa2, pa3); C *= tot; }                                                      \
        else { float alpha;                                                                                                        \
            fox_weights<1, MASK_>(PC, pdum, fk_, dq_, m_run, l_run, alpha, pa0, pa1, pa2, pa3);                                     \
            if (__any(alpha < 1.0f)) { if (hi == 0) wsm[r32] = alpha;                                                               \
                _Pragma("unroll") for (int r = 0; r < 16; ++r) { const float al = wsm[crow(r, hi)];                                 \
                    _Pragma("unroll") for (int d = 0; d < 4; ++d) o[d][r] *= al; } } } } while (0)
#define PB_HALF(UP_, PC, PN, hk_, kn_, hkn_) do {                                                                                 \
        const bool actC = PB_ACT(hk_), actN = PB_ACT(hkn_);                                                                        \
        if (actC) { bf16x8 pa0, pa1, pa2, pa3; const int dq = trow - (hk_) - 4 * hi;                                               \
            const LAS f32x4* fk = (const LAS f32x4*)(fbuf + buf * 64 + (UP_ ? 32 : 0) + 4 * hi);                                   \
            if (PB_NM(hk_)) { qk_half(PN, kn_, r32, hi, qx, rx); PB_WEIGHTS(true, PC, dq, fk); }                                        \
            else            { qk_half(PN, kn_, r32, hi, qx, rx); PB_WEIGHTS(false, PC, dq, fk); }                                       \
            pv_half<UP_>(o, vrb + buf * SHM_T, pa0, pa1);                                                                           \
        } else if (actN) qk_half(PN, kn_, r32, hi, qx, rx); } while (0)
    int ko = 0;
    for (int it = 0; it < NT; ++it) {
        const int buf = it & 1, kb = PB_KB(it);
        const int ko1 = (ko == 2 * SHM_T) ? 0 : ko + SHM_T, ko2 = (ko1 == 2 * SHM_T) ? 0 : ko1 + SHM_T;
        if (it + 2 < NT) PB_LOADK(it + 2);
        if (it + 1 < NT) PB_LOADV(it + 1);
        bool skip;
        if (MODE == 0) skip = __all(C < NEG_EPS) != 0; else skip = __all(m_run + fbuf[buf * 64 + 63] > zb) != 0;
        if (!skip) {
        PB_HALF(true, pA, pB, kb + 32, Kl + ko, kb);
        PB_HALF(false, pB, pA, kb, Kl + ko1 + 32 * 256, kb - 32);
        }
        if (it + 2 < NT) PB_WRITEK(ko2);
        if (it + 1 < NT) PB_WRITEV(buf ^ 1);
        if (lane == 0) flg[buf * 8 + wid] = skip ? 1 : 0;
        LDS_WAIT(); __syncthreads();
        { const LAS int* f = flg + buf * 8; if ((f[0] & f[1]) & (f[2] & f[3]) & (f[4] & f[5]) & (f[6] & f[7])) break; }
        ko = ko1;
    }
#undef PB_HALF
#undef PB_WEIGHTS
#undef PB_KB
#undef PB_ACT
#undef PB_NM
#undef PB_LOADK
#undef PB_LOADV
#undef PB_WRITEK
#undef PB_WRITEV
    float rli[16];
    if (MODE == 1) { if (hi == 0) wsm[32 + r32] = l_run;
#pragma unroll
        for (int r = 0; r < 16; ++r) rli[r] = __builtin_amdgcn_rcpf(wsm[32 + crow(r, hi)]); }
#pragma unroll
    for (int hf = 0; hf < 2; ++hf) {
        unsigned gq[8][4];
        const unsigned gb = ((unsigned)(qlo + 4 * hi + 16 * hf) * 128u + (unsigned)r32) * 2u;
#pragma unroll
        for (int r = 0; r < 8; ++r)
#pragma unroll
            for (int d = 0; d < 4; ++d)
                asm volatile("global_load_ushort %0, %1, %2 offset:%3" : "=&v"(gq[r][d]) : "v"(gb), "s"(Gh), "n"(((r & 3) + 8 * (r >> 2)) * 256 + 64 * d) : "memory");
        __builtin_amdgcn_sched_barrier(0);
        asm volatile("s_waitcnt vmcnt(0)" ::: "memory");
        __builtin_amdgcn_sched_barrier(0);
#pragma unroll
        for (int r8 = 0; r8 < 8; ++r8) { const int r = 8 * hf + r8; const unsigned row = (unsigned)(qlo + crow(r, hi));
            const unsigned aoff = (row * 2048u + (unsigned)r32) * 2u;
#pragma unroll
            for (int d = 0; d < 4; ++d) {
                float v = o[d][r]; if (MODE == 1) v *= rli[r];
                v *= __builtin_bit_cast(float, gq[r8][d] << 16);
                const float vn = __shfl_xor(v, 1);
                const unsigned w = cvt_pk_bf16(v, vn);
                if ((r32 & 1) == 0) {
                    if (d == 0) asm volatile("global_store_dword %0, %1, %2" :: "v"(aoff), "v"(w), "s"(Ah) : "memory");
                    else if (d == 1) asm volatile("global_store_dword %0, %1, %2 offset:64" :: "v"(aoff), "v"(w), "s"(Ah) : "memory");
                    else if (d == 2) asm volatile("global_store_dword %0, %1, %2 offset:128" :: "v"(aoff), "v"(w), "s"(Ah) : "memory");
                    else asm volatile("global_store_dword %0, %1, %2 offset:192" :: "v"(aoff), "v"(w), "s"(Ah) : "memory"); } } }
    }
    LDS_WAIT(); __syncthreads();
}

template <int MODE>
__device__ __forceinline__ void sample_unit(LAS char* lds, const bf16* Qs, const float* Kc, const float* Vc, const bf16* Kn, const bf16* Vn, const float* F2, const bf16* Gs, bf16* As, const float* Kmx, int wave_) {
    int tid_ = wave_ * 64 + lane_id(); asm volatile("" : "+v"(tid_));
    const int tid = tid_, wid = __builtin_amdgcn_readfirstlane(tid >> 6), lane = tid & 63, r32 = lane & 31, hi = lane >> 5, qrow = r32 & 15;
    LAS char* Kt = lds + wid * 16384; LAS char* Vt = Kt + 8192;
    LAS float* xch = (LAS float*)(lds + XCH_OFF);
    const int vrb = (int)(unsigned)(size_t)Vt + v_rd_base(lane);
    LAS char* Qb = lds + XCH_OFF + 4096;
    if (tid < 256) { const int r = tid >> 4, c = tid & 15; *(LAS bf16x8*)(Qb + r * 256 + ((c ^ r) << 4)) = *(const bf16x8*)(Qs + (size_t)r * 128 + c * 8); }
    LDS_WAIT(); __syncthreads();
    LAS float* qnt = (LAS float*)(lds + XCH_OFF + 8192 + 1024) + wid * 64;
    LAS float* ktb = (LAS float*)(lds + XCH_OFF + 8192) + wid * 32;
    if (MODE == 1) {
        float qn = 0.f;
#pragma unroll
        for (int c = 0; c < 16; ++c) { const bf16x8 qv = *(LAS bf16x8*)(Qb + qrow * 256 + ((c ^ qrow) << 4));
#pragma unroll
            for (int e = 0; e < 8; ++e) { const float f = bf2f(qv[e]); qn += f * f; } }
        qnt[lane] = sqrtf(qn);
        const int tix = 128 - 8 * ((lane & 15) + 1) + 7 - wid;
        float kn = (tix < KN_TILES) ? Kmx[tix] : 0.f;
        kn = fmaxf(kn, __builtin_bit_cast(float, __builtin_amdgcn_update_dpp(0, __builtin_bit_cast(int, kn), 0x128, 0xf, 0xf, false)));
        kn = fmaxf(kn, __builtin_bit_cast(float, __builtin_amdgcn_update_dpp(0, __builtin_bit_cast(int, kn), 0x124, 0xf, 0xf, false)));
        kn = fmaxf(kn, __builtin_bit_cast(float, __builtin_amdgcn_update_dpp(0, __builtin_bit_cast(int, kn), 0x122, 0xf, 0xf, false)));
        kn = fmaxf(kn, __builtin_bit_cast(float, __builtin_amdgcn_update_dpp(0, __builtin_bit_cast(int, kn), 0x121, 0xf, 0xf, false)));
        if (lane < 16) { ktb[lane] = (tix < KN_TILES) ? sqrtf(kn) * 1.01f : 3.0e38f; ktb[16 + lane] = F2[tix * 32 + 31]; }
    }
    f32x16 o[4];
#pragma unroll
    for (int d = 0; d < 4; ++d) o[d] = (f32x16){0.f, 0.f, 0.f, 0.f, 0.f, 0.f, 0.f, 0.f, 0.f, 0.f, 0.f, 0.f, 0.f, 0.f, 0.f, 0.f};
    const __amdgpu_buffer_rsrc_t rk = mk_rsrc(Kc, PAST * 4096), rv = mk_rsrc(Vc, PAST * 4096);
    const int voff = hi * 4096 + r32 * 16;
    int kwa[4]; const int vw0 = v_st(hi, r32 * 4);
#pragma unroll
    for (int q = 0; q < 4; ++q) kwa[q] = KSWZ(2 * q + hi, r32 * 8);
    float R = 1.0f, m_run = -1e30f, l_run = 0.f;
    f32x4 tk[16];
#define SU_SO(rho_) ((PAST - 256 * (rho_) + 32 * (7 - wid)) * 4096)
#define SU_LOADK(rho_) do { const int so_ = SU_SO(rho_); _Pragma("unroll") for (int i = 0; i < 16; ++i) tk[i] = __builtin_bit_cast(f32x4, __builtin_amdgcn_raw_buffer_load_b128(rk, voff, so_ + i * 8192, 2)); } while (0)
#define SU_LOADV(rho_) do { const int so_ = SU_SO(rho_); _Pragma("unroll") for (int i = 0; i < 16; ++i) tk[i] = __builtin_bit_cast(f32x4, __builtin_amdgcn_raw_buffer_load_b128(rv, voff, so_ + i * 8192, 2)); } while (0)
    f32x4 fr[8];
    if (MODE == 1) {
#pragma unroll
        for (int g = 0; g < 4; ++g) fr[2 * g] = *(const f32x4*)(F2 + (PAST - 256 + 32 * (7 - wid)) + 4 * hi + 8 * g); }
    SU_LOADK(1);
    __builtin_amdgcn_sched_barrier(0);
    bool prev_v = true;
    for (int rho = 0; rho <= PAST / 256; ++rho) {
        const bool valid = (rho > 0) || (wid == 0);
        const int s0 = (rho == 0) ? PAST : PAST - 256 * rho + 32 * (7 - wid);
        f32x16 p0, p1; bf16x8 pa0, pa1, pa2, pa3; float PS[8], GS[8]; float tot = 1.0f; bool need_v = valid, pre_v = false;
        if (valid) {
            if (rho == 0) {
#pragma unroll
                for (int i = 0; i < 4; ++i) { const int idx = lane + 64 * i, row = idx >> 4, ch = idx & 15;
                    const bf16x8 kv = *(const bf16x8*)(Kn + (size_t)row * 128 + ch * 8);
                    const bf16x8 z = (bf16x8){0, 0, 0, 0, 0, 0, 0, 0};
                    *(LAS bf16x8*)(Kt + KSWZ(row, ch * 16)) = kv; *(LAS bf16x8*)(Kt + KSWZ(row + 16, ch * 16)) = z; }
            } else {
#pragma unroll
                for (int i = 0; i < 16; ++i) { u32x2 w; w.x = cvt_pk_bf16(tk[i][0], tk[i][1]); w.y = cvt_pk_bf16(tk[i][2], tk[i][3]); *(LAS u32x2*)(Kt + kwa[i & 3] + (i >> 2) * 2048) = w; }
                __builtin_amdgcn_sched_barrier(0);
                pre_v = (MODE == 0) || prev_v;
                if (pre_v) SU_LOADV(rho);
                __builtin_amdgcn_sched_barrier(0);
            }
            qkt_qlds(p0, Kt, Qb, r32, hi, qrow);
            const int dq = qrow - 4 * hi;
            if (MODE == 0) { if (rho == 0) tot = sb_step_a<1, true>(p0, p1, dq, hi, PS, GS); else tot = sb_step_a<1, false>(p0, p1, dq, hi, PS, GS); }
            else { float alpha, ps;
                if (rho == 0) ps = fox_weights<1, true>(p0, p1, (const f32x4*)(F2 + s0 + 4 * hi), dq, m_run, l_run, alpha, pa0, pa1, pa2, pa3);
                else { ps = fox_weights<1, false>(p0, p1, (const f32x4*)fr, dq, m_run, l_run, alpha, pa0, pa1, pa2, pa3);
                    if (rho < PAST / 256) {
#pragma unroll
                        for (int g = 0; g < 4; ++g) fr[2 * g] = *(const f32x4*)(F2 + s0 - 256 + 4 * hi + 8 * g); } }
                need_v = __any(ps != 0.0f) != 0;
                if (__any(alpha < 1.0f)) { LAS float* al = xch + 768 + wid * 32; if (hi == 0) al[r32] = alpha;
#pragma unroll
                    for (int r = 0; r < 16; ++r) { const float a_ = al[crow(r, hi)];
#pragma unroll
                        for (int d = 0; d < 4; ++d) o[d][r] *= a_; } }
            }
        }
        if (MODE == 0) {
            LAS float* xr = xch + (rho & 1) * 256;
            if (hi == 0) xr[wid * 32 + r32] = tot;
            LDS_WAIT(); __builtin_amdgcn_s_barrier(); asm volatile("" ::: "memory");
            float Cin = R;
#pragma unroll
            for (int w = 0; w < 8; ++w) { const float tw = xr[w * 32 + r32]; if (w < wid) Cin *= tw; R *= tw; }
            if (valid) sb_step_b<1>(p0, p1, Cin, PS, GS, pa0, pa1, pa2, pa3);
        }
        const bool more = (rho < PAST / 256) && !(MODE == 0 && rho > 0 && __all(R < NEG_EPS)) && !(MODE == 1 && rho > 0 && __all(qnt[lane] * ktb[rho & 15] - ktb[16 + (rho & 15)] - m_run < -NEG_BITS));
        if (need_v) {
            if (rho == 0) {
#pragma unroll
                for (int i = 0; i < 4; ++i) { const int idx = lane + 64 * i, row = idx >> 4, ch = idx & 15;
                    const bf16x8 vv = *(const bf16x8*)(Vn + (size_t)row * 128 + ch * 8);
                    const bf16x8 z = (bf16x8){0, 0, 0, 0, 0, 0, 0, 0};
                    *(LAS bf16x8*)(Vt + v_st(row, ch * 8)) = vv; *(LAS bf16x8*)(Vt + v_st(row + 16, ch * 8)) = z; }
            } else {
                if (!pre_v) SU_LOADV(rho);
#pragma unroll
                for (int i = 0; i < 16; ++i) { u32x2 w; w.x = cvt_pk_bf16(tk[i][0], tk[i][1]); w.y = cvt_pk_bf16(tk[i][2], tk[i][3]); *(LAS u32x2*)(Vt + vw0 + ((i >> 1) & 1) * 2048 + (i & 1) * 128 + (i >> 3) * 4096 + ((i >> 2) & 1) * 256) = w; }
            }
            __builtin_amdgcn_sched_barrier(0);
            if (rho > 0 && more) SU_LOADK(rho + 1);
            __builtin_amdgcn_sched_barrier(0);
            pv_tile<1>(o, vrb, pa0, pa1, pa2, pa3);
        } else if (rho > 0 && more) SU_LOADK(rho + 1);
        if (rho > 0) prev_v = need_v;
        if (!more) break;
    }
#undef SU_SO
#undef SU_LOADK
#undef SU_LOADV
    LDS_WAIT(); __syncthreads();
    int tid2 = wave_ * 64 + lane_id(); asm volatile("" : "+v"(tid2));
    { const int l2 = tid2 & 63, c2 = l2 & 31, h2 = l2 >> 5;
    if (MODE == 1 && h2 == 0 && c2 < 16) { xch[512 + wid * 16 + c2] = m_run; xch[640 + wid * 16 + c2] = l_run; }
    LAS float* Op = (LAS float*)(lds + wid * 16384) + 4 * h2 * 128 + c2;
#pragma unroll
    for (int d = 0; d < 4; ++d)
#pragma unroll
        for (int r = 0; r < 8; ++r) Op[((r & 3) + 8 * (r >> 2)) * 128 + d * 32] = o[d][r]; }
    LDS_WAIT(); __syncthreads();
    {
        const int row = tid2 >> 5, col = (tid2 & 31) * 4;
        f32x4 num = (f32x4){0.f, 0.f, 0.f, 0.f}; float den = 0.f, M = -1e30f;
        const LAS float* xm = xch + 512 + row;
        if (MODE == 1) {
#pragma unroll 1
            for (int w = 0; w < 8; ++w) M = fmaxf(M, xm[w * 16]); }
        const LAS char* opb = lds + (row * 128 + col) * 4;
#pragma unroll 1
        for (int w = 0; w < 8; ++w) { const f32x4 v = *(const LAS f32x4*)(opb + w * 16384);
            if (MODE == 1) { const float f = __builtin_amdgcn_exp2f(xm[w * 16] - M); num += v * f; den += f * xm[128 + w * 16]; } else num += v; }
        if (MODE == 1) num = num * (1.0f / den);
        const u32x2 gw = *(const u32x2*)(Gs + (size_t)row * 128 + col);
        u32x2 ow; ow.x = cvt_pk_bf16(num[0] * bf_lo(gw.x), num[1] * bf_hi(gw.x)); ow.y = cvt_pk_bf16(num[2] * bf_lo(gw.y), num[3] * bf_hi(gw.y));
        *(u32x2*)(As + (size_t)row * 2048 + col) = ow;
    }
    LDS_WAIT(); __syncthreads();
}
}

struct Args { const float* in[15]; float* out; unsigned char* ws; int ph_lo, ph_hi, li, pad; };

__global__ void __launch_bounds__(512, 2) fwd(Args args) {
    extern __shared__ __attribute__((aligned(16))) unsigned char lds_raw[];
    LAS unsigned char* lds = (LAS unsigned char*)lds_raw;
    const int wave = __builtin_amdgcn_readfirstlane((int)threadIdx.x >> 6);
#define lane (lane_id())
#define tid (wave * 64 + lane_id())
    const int G = gridDim.x;
    Ptrs P;
    P.xp = args.in[0]; P.xs = args.in[1]; P.csbk = args.in[2]; P.csbv = args.in[3]; P.cfxk = args.in[4]; P.cfxv = args.in[5]; P.cflf = args.in[6]; P.normw = args.in[7];
    P.win = args.in[8]; P.bfor = args.in[9]; P.qnw = args.in[10]; P.knw = args.in[11]; P.wbsb = args.in[12]; P.wbfx = args.in[13]; P.wout = args.in[14];
    P.out = args.out; P.ws = args.ws;
    volatile LAS unsigned* MISC = (volatile LAS unsigned*)(lds + MISC_OFF);
    if (tid < 64) MISC[tid] = 0u;
    __syncthreads();
    unsigned* ctl = (unsigned*)(P.ws + WS_CTL);
    XcdBarrier bar; bar.bar = ctl + args.li * 4096; bar.x = 0; bar.st = nullptr; bar.wave = wave;
    if (N_LAUNCHES != N_PHASES) bar = xcd_barrier_post(ctl + args.li * 4096, MISC + 8, wave);
    const int lo = args.ph_lo, hi_ = args.ph_hi;
#define IN(k) (lo <= (k) && (k) < hi_)
#define BOTH(k) (IN(k) && IN((k) + 1))
#define GRID_BAR() do { if (N_LAUNCHES != N_PHASES) xcd_barrier(bar); } while (0)

    if (IN(0)) { p0_prologue(P, lds, blockIdx.x * 8 + wave, G * 8, wave, lane, tid);
        if (PROBE_DOUBLE == 0) { __syncthreads(); p0_prologue(P, lds, blockIdx.x * 8 + wave, G * 8, wave, lane, tid); }
        if (BOTH(0)) GRID_BAR(); }

    if (IN(1)) {
        pg8::Gemm g{(const bf16*)(P.ws + WS_H), (const bf16*)(P.ws + WS_WIN), TT, NPROJ, DM};
        pg8::StaticOrder S; S.init(TT, NPROJ, G, (int)blockIdx.x, WGM_P1);
        pg8::EpiInProj E{P.ws, P.out, P.qnw, P.knw, (LAS float*)(lds + XCH_OFF)};
        pg8::gemm_phase<pg8::EpiInProj, pg8::StaticOrder, true, true>(lds, g, S, E, wave);
        if (PROBE_DOUBLE == 1) { GRID_BAR(); pg8::gemm_phase<pg8::EpiInProj, pg8::StaticOrder, true, true>(lds, g, S, E, wave); }
        { const int ex = ((TT / 256) * (NPROJ / 256)) % G, nside = (ex > 0 && ex < G) ? G - ex : G, sid = (ex > 0 && ex < G) ? (int)blockIdx.x - ex : (int)blockIdx.x;
          if (sid >= 0) { __syncthreads();
              for (int id = sid; id < 8 + NBAT * NH; id += nside) scan_seq(P, lds, id, tid);
              p1_side_weights(P, lds, sid * 8 + wave, nside * 8, wave, lane);
              p1_side_knorm(P, sid * 8 + wave, nside * 8, lane); } }
        if (BOTH(1)) GRID_BAR();
    }

    if (IN(2)) {
        const bf16* ACT = (const bf16*)(P.ws + WS_ACT); constexpr size_t AS = ACT_STRIDE / 2;
        bf16* ACAT = (bf16*)(P.ws + WS_ACAT);
        LAS int* slot = (LAS int*)(lds + MISC_OFF + 64);
        float zb;
        { float a = fmaxf(fabsf(P.qnw[lane]), fabsf(P.qnw[lane + 64])), b = fmaxf(fabsf(P.knw[lane]), fabsf(P.knw[lane + 64]));
#pragma unroll
          for (int o = 1; o < 64; o <<= 1) { a = fmaxf(a, __shfl_xor(a, o)); b = fmaxf(b, __shfl_xor(b, o)); }
          zb = __builtin_bit_cast(float, __builtin_amdgcn_readfirstlane(__builtin_bit_cast(unsigned, 128.0f * a * b * QSCALE * 1.02f + NEG_BITS))); }
#define DQ_NEXT(q, var) do { if (tid == 0) *slot = (int)__hip_atomic_fetch_add(ctl + CW_QUEUE + 64 * (q), 1u, __ATOMIC_RELAXED, __HIP_MEMORY_SCOPE_AGENT); LDS_WAIT(); __syncthreads(); var = *slot; __syncthreads(); } while (0)
        { constexpr int qo = 0;
        if ((((int)blockIdx.x >> 3) & 1) == 0) { const int u = ((int)blockIdx.x >> 4) * 8 + ((int)blockIdx.x & 7);
            const int b = u >> 3, h = u & 7;
            const size_t ro = ((size_t)h * TT + TP + 16 * b) * 128, co = ((size_t)b * PAST * NH + h) * HD;
            att::sample_unit<1>((LAS char*)lds, ACT + A_QFX * AS + ro, P.cfxk + co, P.cfxv + co, ACT + A_KFX * AS + ro, ACT + A_VFX * AS + ro,
                                (const float*)(P.ws + WS_F2S) + (size_t)(b * 8 + h) * KT, ACT + A_GFX * AS + ro, ACAT + (size_t)(TP + 16 * b) * 2048 + 1024 + 128 * h, (const float*)(P.ws + WS_KMX) + (size_t)(b * 8 + h) * 128, wave); }
#define DQ_HEADS(QB, cur, u, hsel) do { if (wave == 0) { int hs_ = (cur), uu_ = 32;                                                                              \
            for (;;) { unsigned v_ = 0u; if (lane == 0) v_ = __hip_atomic_fetch_add(ctl + CW_QUEUE + 64 * ((QB) + hs_), 1u, __ATOMIC_RELAXED, __HIP_MEMORY_SCOPE_AGENT);   \
                uu_ = __builtin_amdgcn_readfirstlane((int)v_); if (uu_ < 32) break;                                                                                 \
                unsigned c_ = 32u; if (lane < 8) c_ = __hip_atomic_load(ctl + CW_QUEUE + 64 * ((QB) + lane), __ATOMIC_RELAXED, __HIP_MEMORY_SCOPE_AGENT);               \
                const unsigned m_ = (unsigned)__ballot(c_ < 32u) & 0xffu; if (m_ == 0u) { hs_ = -1; break; }                                                       \
                const unsigned rot_ = ((m_ >> home) | (m_ << (8 - home))) & 0xffu; hs_ = (home + __builtin_ctz(rot_)) & 7; }                                       \
            if (lane == 0) { slot[0] = uu_; slot[1] = hs_; } }                                                                                                     \
        LDS_WAIT(); __syncthreads(); u = slot[0]; hsel = slot[1]; __syncthreads(); } while (0)
        const int home = (int)blockIdx.x & 7;
        { int cur = home;
          for (;;) { int u, h; DQ_HEADS(16, cur, u, h); if (h < 0) break; cur = h; const size_t ho = (size_t)h * TT * 128;
              att::prompt_block<1>((LAS char*)lds, ACT + A_QFX * AS + ho, ACT + A_KFX * AS + ho, ACT + A_VFX * AS + ho, (const float*)(P.ws + WS_F2P) + (size_t)h * TP, ACT + A_GFX * AS + ho, ACAT + 1024 + 128 * h, 31 - u, zb, wave); } }
        { int cur = home;
          for (;;) { int u, h; DQ_HEADS(24, cur, u, h); if (h < 0) break; cur = h; const size_t ho = (size_t)h * TT * 128;
              att::prompt_block<0>((LAS char*)lds, ACT + A_QSB * AS + ho, ACT + A_KSB * AS + ho, ACT + A_VSB * AS + ho, (const float*)(P.ws + WS_F2P), ACT + A_GSB * AS + ho, ACAT + 128 * h, 31 - u, zb, wave); } }
#undef DQ_HEADS
        for (;;) { int u; DQ_NEXT(qo + 3, u); if (u >= NBAT * NH) break;
            const int b = u >> 3, h = u & 7;
            const size_t ro = ((size_t)h * TT + TP + 16 * b) * 128, co = ((size_t)b * PAST * NH + h) * HD;
            att::sample_unit<0>((LAS char*)lds, ACT + A_QSB * AS + ro, P.csbk + co, P.csbv + co, ACT + A_KSB * AS + ro, ACT + A_VSB * AS + ro,
                                (const float*)(P.ws + WS_F2S), ACT + A_GSB * AS + ro, ACAT + (size_t)(TP + 16 * b) * 2048 + 128 * h, nullptr, wave); }
        }
#undef DQ_NEXT
        if (BOTH(2)) GRID_BAR();
    }
    if (IN(3)) {
        pg8::Gemm g{(const bf16*)(P.ws + WS_ACAT), (const bf16*)(P.ws + WS_WB), TP, DM, DM};
        pg8::StaticOrder S; S.init(TP, DM, G, (int)blockIdx.x, WGM_P3);
        for (int u = blockIdx.x; u < 256; u += G)
            mini_gemm<0>(lds, (const bf16*)(P.ws + WS_ACAT) + (size_t)TP * 2048, (const bf16*)(P.ws + WS_WB), u, wave, lane, tid, (const bf16*)(P.ws + WS_MSIG) + (size_t)TP * 4096, (bf16*)(P.ws + WS_MRG) + (size_t)TP * 2048, nullptr, nullptr);
        pg8::EpiMerge E{(const bf16*)(P.ws + WS_MSIG), (bf16*)(P.ws + WS_MRG)};
        pg8::gemm_phase<pg8::EpiMerge, pg8::StaticOrder, true, true>(lds, g, S, E, wave);
        if (PROBE_DOUBLE == 3) { GRID_BAR(); pg8::gemm_phase<pg8::EpiMerge, pg8::StaticOrder, true, true>(lds, g, S, E, wave); }
        if (BOTH(3)) GRID_BAR();
    }

    if (IN(4)) {
        pg8::Gemm g{(const bf16*)(P.ws + WS_MRG), (const bf16*)(P.ws + WS_WO), TP, DM, DM};
        pg8::StaticOrder S; S.init(TP, DM, G, (int)blockIdx.x, WGM_P4);
        for (int u = blockIdx.x; u < 256; u += G)
            mini_gemm<1>(lds, (const bf16*)(P.ws + WS_MRG) + (size_t)TP * 2048, (const bf16*)(P.ws + WS_WO), u, wave, lane, tid, nullptr, nullptr, P.xs, P.out + O_YS);
        pg8::EpiOut E{P.xp, P.xs, P.out};
        pg8::gemm_phase<pg8::EpiOut, pg8::StaticOrder, true, true>(lds, g, S, E, wave);
    }
#undef IN
#undef BOTH
#undef GRID_BAR
#undef lane
#undef tid
}

extern "C" void kernel_launch(void* const* d_in, const int* in_sizes, int n_in, void* d_out, int out_size, void* d_ws, size_t ws_size, hipStream_t stream) {
    static int grid = 0;
    if (grid == 0) {
        if (n_in != 15 || out_size != (int)O_END || ws_size < WS_END) { fprintf(stderr, "kernel_launch: unexpected shapes (n_in %d, out %d, ws %zu)\n", n_in, out_size, ws_size); grid = -1; return; }
        int dev = 0, cus = 0, per_cu = 0;
        if (hipGetDevice(&dev) != hipSuccess || hipDeviceGetAttribute(&cus, hipDeviceAttributeMultiprocessorCount, dev) != hipSuccess) { grid = -1; return; }
        if (hipFuncSetAttribute((const void*)fwd, hipFuncAttributeMaxDynamicSharedMemorySize, LDS_BYTES) != hipSuccess) { fprintf(stderr, "kernel_launch: hipFuncSetAttribute failed\n"); grid = -1; return; }
        if (hipOccupancyMaxActiveBlocksPerMultiprocessor(&per_cu, (const void*)fwd, 512, LDS_BYTES) != hipSuccess || per_cu < 1) fprintf(stderr, "kernel_launch: occupancy query reports %d\n", per_cu);
        (void)hipGetLastError();
        grid = cus;
    }
    if (grid < 0) return;
    if (hipMemsetAsync((char*)d_ws + WS_CTL, 0, CTL_ZERO_BYTES, stream) != hipSuccess) return;
    Args a{};
    for (int i = 0; i < 15; ++i) a.in[i] = (const float*)d_in[i];
    a.out = (float*)d_out; a.ws = (unsigned char*)d_ws;
    for (int li = 0; li < N_LAUNCHES; ++li) {
        if (N_LAUNCHES == N_PHASES) { a.ph_lo = li; a.ph_hi = li + 1; } else { a.ph_lo = 0; a.ph_hi = N_PHASES; }
        a.li = li; a.pad = 0;
        hipLaunchKernelGGL(fwd, dim3(grid), dim3(512), LDS_BYTES, stream, a);
        const hipError_t le = hipPeekAtLastError();
        if (le != hipSuccess) { fprintf(stderr, "kernel_launch: launch %d failed: %s\n", li, hipGetErrorName(le)); break; }
    }
}
```

```cpp
#include <hip/hip_runtime.h>
#include <cstdio>
#include <cstdint>

#ifndef MK_N_LAUNCHES
#define MK_N_LAUNCHES 1
#endif
#ifndef PROBE_DOUBLE
#define PROBE_DOUBLE -1
#endif
constexpr int N_PHASES = 5;
constexpr int N_LAUNCHES = MK_N_LAUNCHES;

#define GAS __attribute__((address_space(1)))
#define LAS __attribute__((address_space(3)))
typedef unsigned short bf16;
typedef short bf16x8 __attribute__((ext_vector_type(8)));
typedef short s16x4 __attribute__((ext_vector_type(4)));
typedef float f32x4 __attribute__((ext_vector_type(4)));
typedef float f32x16 __attribute__((ext_vector_type(16)));
typedef unsigned u32x4 __attribute__((ext_vector_type(4)));
typedef unsigned u32x2 __attribute__((ext_vector_type(2)));

constexpr int DM = 2048, TP = 8192, NBAT = 16, NSEQ = 16, PAST = 4096, NH = 8, HD = 128, WB = 1024;
constexpr int TS = NBAT * NSEQ;
constexpr int TT = TP + TS;
constexpr int DIN = 12296, NPROJ = 12288;
constexpr int KT = PAST + NSEQ;
constexpr float RMS_EPS = 1e-6f;
constexpr float LOG2E = 1.4426950408889634f;
constexpr float QSCALE = 0.08838834764831845f * 1.4426950408889634f;

constexpr size_t O_YP = 0, O_YS = 16777216, O_PSBK = 17301504, O_PSBV = 25690112, O_PFXK = 34078720, O_PFXV = 42467328, O_PLF = 50855936,
                 O_SSBK = 50921472, O_SSBV = 51183616, O_SFXK = 51445760, O_SFXV = 51707904, O_SLF = 51970048, O_END = 51972096;

constexpr size_t MiB = 1u << 20;
constexpr size_t WS_CTL = 0, CTL_ZERO_BYTES = 1 * MiB;
constexpr int CW_QUEUE = 32768;
constexpr size_t WS_WIN = 2 * MiB;
constexpr size_t WS_WB = 50 * MiB;
constexpr size_t WS_WO = 58 * MiB;
constexpr size_t WS_H = 66 * MiB;
constexpr size_t WS_ACT = 99 * MiB, ACT_STRIDE = 17 * MiB;
constexpr size_t WS_MSIG = 235 * MiB;
constexpr size_t WS_ACAT = 301 * MiB;
constexpr size_t WS_MRG = 334 * MiB;
constexpr size_t WS_F2P = 367 * MiB;
constexpr size_t WS_F2S = 368 * MiB;
constexpr size_t WS_KMX = 372 * MiB;
constexpr size_t WS_END = 373 * MiB;
constexpr int KN_TILES = 96;
constexpr int WGM_P1 = 3, WGM_P3 = 4, WGM_P4 = 4;
constexpr float NEG_BITS = 40.0f, NEG_EPS = 9.0e-13f;
enum { A_QSB = 0, A_KSB, A_VSB, A_GSB, A_QFX, A_KFX, A_VFX, A_GFX };

constexpr int LDS_BYTES = 163840;
constexpr int XCH_OFF = 131072;
constexpr int MISC_OFF = 163328;

#define LDS_WAIT() asm volatile("s_waitcnt lgkmcnt(0)" ::: "memory")
#define VM_WAIT() asm volatile("s_waitcnt vmcnt(0)" ::: "memory")
__device__ __forceinline__ unsigned cvt_pk_bf16(float lo, float hi) { unsigned r; asm volatile("v_cvt_pk_bf16_f32 %0, %1, %2" : "=v"(r) : "v"(lo), "v"(hi)); return r; }
__device__ __forceinline__ float bf_lo(unsigned w) { return __builtin_bit_cast(float, w << 16); }
__device__ __forceinline__ float bf_hi(unsigned w) { return __builtin_bit_cast(float, w & 0xffff0000u); }
__device__ __forceinline__ float bf2f(bf16 v) { return __builtin_bit_cast(float, (unsigned)v << 16); }
__device__ __forceinline__ float fast_sigmoid(float v) { return __builtin_amdgcn_rcpf(1.0f + __builtin_amdgcn_exp2f(-v * LOG2E)); }

__device__ __forceinline__ int lane_id() { int r; asm volatile("v_mbcnt_lo_u32_b32 %0, -1, 0\n\tv_mbcnt_hi_u32_b32 %0, -1, %0" : "=v"(r)); return r; }
namespace pg8 {
constexpr int BM = 256, BK = 64, HALF = 128, HTB = HALF * BK * 2, STAGE_BYTES = 8 * HTB, NXCD = 8;
__host__ __device__ __forceinline__ int lds_byte(int r, int c) { const int st = (r >> 4) * 2 + (c >> 5), rr = r & 15, cc = c & 31, ob = rr * 64 + cc * 2; return st * 1024 + (ob ^ (((ob >> 9) & 1) << 5)); }
__host__ __device__ __forceinline__ void stage_rc(int b, int& R, int& C) { const int st = b / 1024, sb = b % 1024, swz = sb ^ (((sb >> 9) & 1) << 5); R = (st >> 1) * 16 + swz / 64; C = (st & 1) * 32 + (swz % 64) / 2; }
__host__ __device__ __forceinline__ int perm32(int rho) { const int n = rho >> 4, i = rho & 15; return 8 * (i >> 2) + 4 * n + (i & 3); }

struct Unit { int pm, pn; };
struct Gemm { const bf16* A; const bf16* Bt; int M, N, K; };

struct StaticOrder {
    int nM, nN, nwg, G, c, WGM;
    __host__ __device__ void init(int M, int N, int G_, int c_, int wgm_) { nM = M / BM; nN = N / BM; nwg = nM * nN; G = G_; c = c_; WGM = wgm_; }
    __host__ __device__ bool next(int i, Unit& u) const {
        const long L = (long)i * G + c; if (L >= nwg) return false;
        int wgid = (int)L; { const int q = nwg / NXCD, r = nwg % NXCD, xcd = wgid % NXCD, off = wgid / NXCD; wgid = (xcd < r ? xcd * (q + 1) : r * (q + 1) + (xcd - r) * q) + off; }
        const int nig = WGM * nN, gid = wgid / nig, fm = gid * WGM, gsz = (nM - fm) < WGM ? (nM - fm) : WGM;
        u.pm = fm + ((wgid % nig) % gsz); u.pn = (wgid % nig) / gsz; return true;
    }
    __device__ __forceinline__ void a_ready(const Unit&) const {}
    __device__ __forceinline__ void done(const Unit&) const {}
};


struct EpiInProj {
    static constexpr bool PERM = true, AFTER_DRAIN = false, MIDK = false;
    unsigned char* ws; float* out; const float* qnw; const float* knw; LAS float* xch;
    __device__ __forceinline__ void operator()(f32x4 (&acc)[2][2][4][2], const Unit& u, int wr, int wc, int fr, int fq) const {
        const int grp = u.pn >> 2;
        const int rowl0 = wr * 64 + fr, colq = wc * 32 + 8 * fq;
        const bool sample = (u.pm >= TP / 256);
        if (grp == 4 || grp == 5) {
            const float* nw = (grp == 4) ? qnw : knw;
            const f32x4 w0 = *(const f32x4*)(nw + colq), w1 = *(const f32x4*)(nw + colq + 4);
#pragma unroll
            for (int ai = 0; ai < 2; ++ai)
#pragma unroll
                for (int m = 0; m < 4; ++m)
#pragma unroll
                    for (int bj = 0; bj < 2; ++bj) {
                        const f32x4 a = acc[ai][bj][m][0], b = acc[ai][bj][m][1];
                        float s = (a[0] * a[0] + a[1] * a[1]) + (a[2] * a[2] + a[3] * a[3]) + (b[0] * b[0] + b[1] * b[1]) + (b[2] * b[2] + b[3] * b[3]);
                        s += __shfl_xor(s, 16); s += __shfl_xor(s, 32);
                        if (fq == 0) xch[(ai * 128 + rowl0 + 16 * m) * 8 + bj * 4 + wc] = s;
                    }
            LDS_WAIT(); __builtin_amdgcn_s_barrier(); asm volatile("" ::: "memory");
            const float post = (grp == 4) ? QSCALE : 1.0f;
#pragma unroll
            for (int ai = 0; ai < 2; ++ai)
#pragma unroll
                for (int m = 0; m < 4; ++m)
#pragma unroll
                    for (int bj = 0; bj < 2; ++bj) {
                        const f32x4 t = *(const LAS f32x4*)(xch + (ai * 128 + rowl0 + 16 * m) * 8 + bj * 4);
                        const float tot = (t[0] + t[1]) + (t[2] + t[3]);
                        const float rs = __builtin_amdgcn_rsqf(tot * (1.0f / 128.0f) + RMS_EPS) * post;
                        acc[ai][bj][m][0] = acc[ai][bj][m][0] * rs * w0; acc[ai][bj][m][1] = acc[ai][bj][m][1] * rs * w1;
                    }
        }
        bf16* bdst; int bld; int bcol0; float* fdst = nullptr; int mode = 0;
        if (grp < 8) { bdst = (bf16*)(ws + WS_ACT + (size_t)grp * ACT_STRIDE); bld = 1024; bcol0 = (u.pn & 3) * 256;
            if (grp == 0) mode = 1; else if (grp == 3 || grp == 7) mode = 2;
            if (grp == 1) fdst = out + (sample ? O_SSBK : O_PSBK); else if (grp == 2) fdst = out + (sample ? O_SSBV : O_PSBV);
            else if (grp == 5) fdst = out + (sample ? O_SFXK : O_PFXK); else if (grp == 6) fdst = out + (sample ? O_SFXV : O_PFXV);
        } else { bdst = (bf16*)(ws + WS_MSIG); bld = 4096; bcol0 = (u.pn - 32) * 256; mode = 3; }
        const int frow_off = sample ? TP : 0;
#pragma unroll
        for (int ai = 0; ai < 2; ++ai)
#pragma unroll
            for (int m = 0; m < 4; ++m) {
                const int row = u.pm * 256 + ai * 128 + rowl0 + 16 * m;
#pragma unroll
                for (int bj = 0; bj < 2; ++bj) {
                    f32x4 v0 = acc[ai][bj][m][0], v1 = acc[ai][bj][m][1];
                    const int col = bcol0 + bj * 128 + colq;
                    if (fdst) { float* fp = fdst + (size_t)(row - frow_off) * 1024 + col; *(f32x4*)fp = v0; *(f32x4*)(fp + 4) = v1; }
                    if (mode == 1) { v0 = v0 * QSCALE; v1 = v1 * QSCALE; }
                    else if (mode == 2) {
#pragma unroll
                        for (int j = 0; j < 4; ++j) { v0[j] = v0[j] * fast_sigmoid(v0[j]); v1[j] = v1[j] * fast_sigmoid(v1[j]); } }
                    else if (mode == 3) {
#pragma unroll
                        for (int j = 0; j < 4; ++j) { v0[j] = fast_sigmoid(v0[j]); v1[j] = fast_sigmoid(v1[j]); } }
                    u32x4 w; w.x = cvt_pk_bf16(v0[0], v0[1]); w.y = cvt_pk_bf16(v0[2], v0[3]); w.z = cvt_pk_bf16(v1[0], v1[1]); w.w = cvt_pk_bf16(v1[2], v1[3]);
                    if (grp < 8) *(u32x4*)(bdst + ((size_t)(((u.pn & 3) * 2 + bj) * TT + row)) * 128 + colq) = w;
                    else if (sample) *(u32x4*)(bdst + (size_t)row * bld + col) = w;
                    else *(u32x4*)(bdst + (size_t)(u.pm * 16 + (u.pn - 32)) * 65536 + (size_t)((ai * 4 + m) * 2 + bj) * 4096 + (size_t)(((wr * 4 + wc) * 64 + fq * 16 + fr) * 8)) = w;
                }
            }
    }
};

struct EpiMerge {
    static constexpr bool PERM = true, AFTER_DRAIN = false, MIDK = true;
    const bf16* msig; bf16* mrg;
    template <bool FINAL>
    __device__ __forceinline__ void apply(f32x4 (&acc)[2][2][4][2], const Unit& u, int wr, int wc, int fr, int fq) const {
        const int rowl0 = wr * 64 + fr, colq = wc * 32 + 8 * fq;
        int pm_ = u.pm; asm volatile("" : "+s"(pm_));
#pragma unroll
        for (int ai = 0; ai < 2; ++ai)
#pragma unroll
            for (int m = 0; m < 4; ++m) {
                const int row = pm_ * 256 + ai * 128 + rowl0 + 16 * m;
#pragma unroll
                for (int bj = 0; bj < 2; ++bj) {
                    const int col = u.pn * 256 + bj * 128 + colq;
                    const bf16* gt = msig + (size_t)(pm_ * 16 + u.pn) * 65536 + (size_t)((ai * 4 + m) * 2 + bj) * 4096 + (size_t)(((wr * 4 + wc) * 64 + fq * 16 + fr) * 8);
                    const u32x4 gf = *(const u32x4*)(gt + (size_t)8 * 65536);
                    float f[8] = {bf_lo(gf.x), bf_hi(gf.x), bf_lo(gf.y), bf_hi(gf.y), bf_lo(gf.z), bf_hi(gf.z), bf_lo(gf.w), bf_hi(gf.w)};
#pragma unroll
                    for (int j = 0; j < 8; ++j) f[j] = fmaxf(f[j], 1e-30f);
                    if (!FINAL) {
                        const u32x4 gs = *(const u32x4*)gt;
                        const float s[8] = {bf_lo(gs.x), bf_hi(gs.x), bf_lo(gs.y), bf_hi(gs.y), bf_lo(gs.z), bf_hi(gs.z), bf_lo(gs.w), bf_hi(gs.w)};
#pragma unroll
                        for (int j = 0; j < 4; ++j) { acc[ai][bj][m][0][j] *= s[j] * __builtin_amdgcn_rcpf(f[j]); acc[ai][bj][m][1][j] *= s[4 + j] * __builtin_amdgcn_rcpf(f[4 + j]); }
                    } else {
                        const f32x4 v0 = acc[ai][bj][m][0], v1 = acc[ai][bj][m][1];
                        u32x4 w; w.x = cvt_pk_bf16(v0[0] * f[0], v0[1] * f[1]); w.y = cvt_pk_bf16(v0[2] * f[2], v0[3] * f[3]);
                        w.z = cvt_pk_bf16(v1[0] * f[4], v1[1] * f[5]); w.w = cvt_pk_bf16(v1[2] * f[6], v1[3] * f[7]);
                        *(u32x4*)(mrg + (size_t)row * 2048 + col) = w;
                    }
                    asm volatile("" ::: "memory");
                }
            }
    }
    __device__ __forceinline__ void mid(f32x4 (&acc)[2][2][4][2], const Unit& u, int wr, int wc, int fr, int fq) const { apply<false>(acc, u, wr, wc, fr, fq); }
    __device__ __forceinline__ void operator()(f32x4 (&acc)[2][2][4][2], const Unit& u, int wr, int wc, int fr, int fq) const { apply<true>(acc, u, wr, wc, fr, fq); }
};

struct EpiOut {
    static constexpr bool PERM = false, AFTER_DRAIN = false, MIDK = false;
    const float* xp; const float* xs; float* y;
    __device__ __forceinline__ void operator()(f32x4 (&acc)[2][2][4][2], const Unit& u, int wr, int wc, int fr, int fq) const {
        const int rowl0 = wr * 64 + fr, colq = wc * 32 + 4 * fq;
#pragma unroll
        for (int ai = 0; ai < 2; ++ai)
#pragma unroll
            for (int m = 0; m < 4; ++m) {
                const int row = u.pm * 256 + ai * 128 + rowl0 + 16 * m;
                const float* xr = (row < TP) ? xp + (size_t)row * DM : xs + (size_t)(row - TP) * DM;
                float* yr = y + (size_t)row * DM;
#pragma unroll
                for (int bj = 0; bj < 2; ++bj)
#pragma unroll
                    for (int n = 0; n < 2; ++n) { const int c = u.pn * 256 + bj * 128 + colq + 16 * n; *(f32x4*)(yr + c) = acc[ai][bj][m][n] + __builtin_nontemporal_load((const f32x4*)(xr + c)); }
                asm volatile("" ::: "memory");
            }
    }
};

template <class Epi, class Sched, bool ALIGN_EPI = false, bool SP2 = false>
__device__ __forceinline__ void gemm_phase(LAS unsigned char* lds, const Gemm g, const Sched& S, const Epi& E, int wave_) {
    const int wid = wave_, lane = lane_id(), tid = wid * 64 + lane, wr = wid >> 2, wc = wid & 3, fr = lane & 15, fq = lane >> 4;
    const int K = g.K, nt = K / BK;
    unsigned voffA[2], voffB[2];
#pragma unroll
    for (int i = 0; i < 2; ++i) { int R, C; stage_rc(tid * 16 + i * 8192, R, C); const int Rb = Epi::PERM ? ((R & ~31) + perm32(R & 31)) : R;
        voffA[i] = (unsigned)(R * K + C) * 2u; voffB[i] = (unsigned)(Rb * K + C) * 2u; }
    const size_t kstep = (size_t)(BK * 2);
    const size_t hstep = (size_t)HALF * K * 2;
    const size_t tstep = 2 * hstep;
    const unsigned ldsw = (unsigned)wid * 1024u;
    const int aoff = lds_byte(wr * 64 + fr, fq * 8), boff = lds_byte(wc * 32 + fr, fq * 8);
#define PG8_SA(b, h) (((b) * 2 + (h)) * HTB)
#define PG8_SB(b, h) ((4 + (b) * 2 + (h)) * HTB)
#define PG8_STAGE(bufoff, gbase, voff) do { _Pragma("unroll") for (int _i = 0; _i < 2; ++_i) \
        __builtin_amdgcn_global_load_lds((const unsigned*)((const char*)(gbase) + (voff)[_i]), (LAS unsigned*)(lds + (bufoff) + ldsw + _i * 8192), 16, 0, 0); } while (0)
#define PG8_LDA(dst, b, h) do { _Pragma("unroll") for (int m = 0; m < 4; ++m) _Pragma("unroll") for (int k = 0; k < 2; ++k) dst[m][k] = *(const LAS bf16x8*)(lds + PG8_SA(b, h) + aoff + m * 2048 + k * 1024); } while (0)
#define PG8_LDB(dst, b, h) do { _Pragma("unroll") for (int n = 0; n < 2; ++n) _Pragma("unroll") for (int k = 0; k < 2; ++k) dst[n][k] = *(const LAS bf16x8*)(lds + PG8_SB(b, h) + boff + n * 2048 + k * 1024); } while (0)
#define PG8_MMA(ai, bj, At, Bt) do { __builtin_amdgcn_s_setprio(1); _Pragma("unroll") for (int m = 0; m < 4; ++m) _Pragma("unroll") for (int n = 0; n < 2; ++n) _Pragma("unroll") for (int k = 0; k < 2; ++k) \
        acc[ai][bj][m][n] = __builtin_amdgcn_mfma_f32_16x16x32_bf16(Bt[n][k], At[m][k], acc[ai][bj][m][n], 0, 0, 0); __builtin_amdgcn_s_setprio(0); } while (0)
#define PG8_WAIT_V(n) asm volatile("s_waitcnt vmcnt(" #n ")" ::: "memory")
#define PG8_WAIT_L(n) asm volatile("s_waitcnt lgkmcnt(" #n ")" ::: "memory")
#define PG8_BAR __builtin_amdgcn_s_barrier()
#define PG8_SCHED __builtin_amdgcn_sched_barrier(0)
    Unit cur, nxt; int ui = 0;
    if (!S.next(0, cur)) return;
    f32x4 acc[2][2][4][2];
#pragma unroll
    for (int a = 0; a < 2; ++a)
#pragma unroll
        for (int b = 0; b < 2; ++b)
#pragma unroll
            for (int m = 0; m < 4; ++m)
#pragma unroll
                for (int n = 0; n < 2; ++n) acc[a][b][m][n] = (f32x4){0.f, 0.f, 0.f, 0.f};
    bf16x8 At[4][2], B0[2][2], B1[2][2];
    const char* cA = (const char*)g.A + (size_t)cur.pm * tstep; const char* cB = (const char*)g.Bt + (size_t)cur.pn * tstep;
    S.a_ready(cur);
    if constexpr (SP2) {
        PG8_STAGE(PG8_SB(0, 0), cB, voffB); PG8_STAGE(PG8_SB(0, 1), cB + hstep, voffB); PG8_STAGE(PG8_SA(0, 0), cA, voffA); PG8_STAGE(PG8_SA(0, 1), cA + hstep, voffA);
        if (wr == 1) PG8_BAR;
        PG8_WAIT_V(2); PG8_BAR;
        PG8_STAGE(PG8_SB(1, 0), cB + kstep, voffB); PG8_STAGE(PG8_SA(1, 0), cA + kstep, voffA); PG8_STAGE(PG8_SB(1, 1), cB + hstep + kstep, voffB);
        PG8_WAIT_V(6); PG8_BAR;
    } else {
        PG8_STAGE(PG8_SB(0, 0), cB, voffB); PG8_STAGE(PG8_SA(0, 0), cA, voffA); PG8_STAGE(PG8_SB(0, 1), cB + hstep, voffB); PG8_STAGE(PG8_SA(0, 1), cA + hstep, voffA);
        if (wr == 1) PG8_BAR;
        PG8_WAIT_V(4); PG8_BAR;
        PG8_STAGE(PG8_SB(1, 0), cB + kstep, voffB); PG8_STAGE(PG8_SA(1, 0), cA + kstep, voffA); PG8_STAGE(PG8_SB(1, 1), cB + hstep + kstep, voffB);
        PG8_WAIT_V(6); PG8_BAR;
    }
    for (;;) {
        const bool has_next = S.next(ui + 1, nxt);
        const char* nA = has_next ? (const char*)g.A + (size_t)nxt.pm * tstep : cA; const char* nB = has_next ? (const char*)g.Bt + (size_t)nxt.pn * tstep : cB;
        for (int t = 0; t < nt; t += 2) {
            const bool last = (t == nt - 2);
            const char* a1 = cA + (size_t)(t + 1) * kstep;
            const char* a2 = last ? nA : cA + (size_t)(t + 2) * kstep; const char* b2 = last ? nB : cB + (size_t)(t + 2) * kstep;
            const char* a3 = a2 + kstep; const char* b3 = b2 + kstep;
            if (last && has_next) S.a_ready(nxt);
            if constexpr (Epi::MIDK) { if (t == nt / 2) E.mid(acc, cur, wr, wc, fr, fq); }
            if constexpr (SP2) {
            PG8_LDB(B0, 0, 0); PG8_LDB(B1, 0, 1); PG8_SCHED; PG8_LDA(At, 0, 0); PG8_STAGE(PG8_SA(1, 1), a1 + hstep, voffA);
            PG8_WAIT_V(8); PG8_WAIT_L(0); PG8_BAR; PG8_MMA(0, 0, At, B0); PG8_MMA(0, 1, At, B1); PG8_BAR; PG8_SCHED;
            PG8_LDA(At, 0, 1); PG8_STAGE(PG8_SB(0, 0), b2, voffB); PG8_STAGE(PG8_SB(0, 1), b2 + hstep, voffB); PG8_STAGE(PG8_SA(0, 0), a2, voffA);
            PG8_WAIT_V(8); PG8_WAIT_L(0); PG8_BAR; PG8_MMA(1, 0, At, B0); PG8_MMA(1, 1, At, B1); PG8_BAR; PG8_SCHED;
            PG8_LDB(B0, 1, 0); PG8_LDB(B1, 1, 1); PG8_SCHED; PG8_LDA(At, 1, 0); PG8_STAGE(PG8_SA(0, 1), a2 + hstep, voffA);
            PG8_WAIT_V(8); PG8_WAIT_L(0); PG8_BAR; PG8_MMA(0, 0, At, B0); PG8_MMA(0, 1, At, B1); PG8_BAR; PG8_SCHED;
            PG8_LDA(At, 1, 1); PG8_STAGE(PG8_SB(1, 0), b3, voffB); PG8_STAGE(PG8_SB(1, 1), b3 + hstep, voffB); PG8_STAGE(PG8_SA(1, 0), a3, voffA);
            PG8_WAIT_V(8); PG8_WAIT_L(0); PG8_BAR; PG8_MMA(1, 0, At, B0); PG8_MMA(1, 1, At, B1); PG8_BAR; PG8_SCHED;
            } else {
            PG8_LDB(B0, 0, 0); PG8_SCHED; PG8_LDA(At, 0, 0); PG8_STAGE(PG8_SA(1, 1), a1 + hstep, voffA);
            PG8_WAIT_L(8); PG8_BAR; PG8_WAIT_L(0); PG8_MMA(0, 0, At, B0); PG8_BAR; PG8_SCHED;
            PG8_LDB(B1, 0, 1); PG8_STAGE(PG8_SB(0, 0), b2, voffB);
            PG8_BAR; PG8_WAIT_L(0); PG8_MMA(0, 1, At, B1); PG8_BAR;
            PG8_LDA(At, 0, 1); PG8_STAGE(PG8_SA(0, 0), a2, voffA);
            PG8_BAR; PG8_WAIT_L(0); PG8_MMA(1, 0, At, B0); PG8_BAR; PG8_SCHED;
            PG8_STAGE(PG8_SB(0, 1), b2 + hstep, voffB);
            PG8_WAIT_V(6); PG8_BAR; PG8_MMA(1, 1, At, B1); PG8_BAR;
            PG8_LDB(B0, 1, 0); PG8_SCHED; PG8_LDA(At, 1, 0); PG8_STAGE(PG8_SA(0, 1), a2 + hstep, voffA);
            PG8_WAIT_L(8); PG8_BAR; PG8_WAIT_L(0); PG8_MMA(0, 0, At, B0); PG8_BAR; PG8_SCHED;
            PG8_LDB(B1, 1, 1); PG8_STAGE(PG8_SB(1, 0), b3, voffB);
            PG8_BAR; PG8_WAIT_L(0); PG8_MMA(0, 1, At, B1); PG8_BAR;
            PG8_LDA(At, 1, 1); PG8_STAGE(PG8_SA(1, 0), a3, voffA);
            PG8_BAR; PG8_WAIT_L(0); PG8_MMA(1, 0, At, B0); PG8_BAR; PG8_SCHED;
            PG8_STAGE(PG8_SB(1, 1), b3 + hstep, voffB);
            PG8_WAIT_V(6); PG8_BAR; PG8_MMA(1, 1, At, B1); PG8_BAR;
            }
        }
        if constexpr (ALIGN_EPI) { if (wr == 0) PG8_BAR; }
        E(acc, cur, wr, wc, fr, fq); S.done(cur);
        if (!has_next) break;
#pragma unroll
        for (int a = 0; a < 2; ++a)
#pragma unroll
            for (int b = 0; b < 2; ++b)
#pragma unroll
                for (int m = 0; m < 4; ++m)
#pragma unroll
                    for (int n = 0; n < 2; ++n) acc[a][b][m][n] = (f32x4){0.f, 0.f, 0.f, 0.f};
        cur = nxt; cA = nA; cB = nB; ++ui;
        if constexpr (ALIGN_EPI) { if (wr == 1) PG8_BAR; }
    }
    PG8_WAIT_V(0);
    if constexpr (!ALIGN_EPI) { if (wr == 0) PG8_BAR; }
    PG8_BAR;
#undef PG8_SA
#undef PG8_SB
#undef PG8_STAGE
#undef PG8_LDA
#undef PG8_LDB
#undef PG8_MMA
#undef PG8_WAIT_V
#undef PG8_WAIT_L
#undef PG8_BAR
#undef PG8_SCHED
}
}

template <int MODE>
__device__ __forceinline__ void mini_gemm(LAS unsigned char* lds, const bf16* A, const bf16* Bt, int unit, int wave, int lane, int tid, const bf16* msig_s, bf16* mrg_s, const float* xs, float* ys) {
    const int r0 = (unit >> 6) * 64, c0 = (unit & 63) * 32;
    const int m = lane & 15, kq = lane >> 4;
    const bf16* ap = A + (size_t)(r0 + m) * 2048 + wave * 256 + 8 * kq;
    const bf16* bp = Bt + (size_t)(c0 + m) * 2048 + wave * 256 + 8 * kq;
    f32x4 acc[4][2];
#pragma unroll
    for (int i = 0; i < 4; ++i) { acc[i][0] = (f32x4){0.f, 0.f, 0.f, 0.f}; acc[i][1] = acc[i][0]; }
    bf16x8 fa[4][4], fb[4][2];
    const bf16* ap1 = ap + 16 * 2048; const bf16* ap2 = ap + 32 * 2048; const bf16* ap3 = ap + 48 * 2048; const bf16* bp1 = bp + 16 * 2048;
#define MG_LD(dst_, ptr_, st_) asm volatile("global_load_dwordx4 %0, %1, off offset:%2" : "=&v"(dst_) : "v"(ptr_), "n"(64 * (st_)) : "memory")
#define MG_LOAD(st_) do { MG_LD(fa[(st_) & 3][0], ap, st_); MG_LD(fa[(st_) & 3][1], ap1, st_); MG_LD(fa[(st_) & 3][2], ap2, st_); MG_LD(fa[(st_) & 3][3], ap3, st_); \
                          MG_LD(fb[(st_) & 3][0], bp, st_); MG_LD(fb[(st_) & 3][1], bp1, st_); } while (0)
    const int rl = tid >> 3, cl = (tid & 7) * 4, row = r0 + rl, col = c0 + cl;
    u32x2 gs, gf; f32x4 xin;
    if (MODE == 0) { gs = *(const u32x2*)(msig_s + (size_t)row * 4096 + col); gf = *(const u32x2*)(msig_s + (size_t)row * 4096 + 2048 + col); }
    else xin = *(const f32x4*)(xs + (size_t)row * 2048 + col);
    __builtin_amdgcn_sched_barrier(0);
    MG_LOAD(0); MG_LOAD(1); MG_LOAD(2); MG_LOAD(3);
#pragma unroll
    for (int st = 0; st < 8; ++st) {
        __builtin_amdgcn_sched_barrier(0);
        if (st <= 4) asm volatile("s_waitcnt vmcnt(18)" ::: "memory"); else if (st == 5) asm volatile("s_waitcnt vmcnt(12)" ::: "memory");
        else if (st == 6) asm volatile("s_waitcnt vmcnt(6)" ::: "memory"); else asm volatile("s_waitcnt vmcnt(0)" ::: "memory");
        __builtin_amdgcn_sched_barrier(0);
#pragma unroll
        for (int i = 0; i < 4; ++i)
#pragma unroll
            for (int j = 0; j < 2; ++j) acc[i][j] = __builtin_amdgcn_mfma_f32_16x16x32_bf16(fb[st & 3][j], fa[st & 3][i], acc[i][j], 0, 0, 0);
        __builtin_amdgcn_sched_barrier(0);
        if (st + 4 < 8) MG_LOAD(st + 4);
    }
#undef MG_LOAD
#undef MG_LD
    LAS float* part = (LAS float*)lds + wave * 2048;
#pragma unroll
    for (int i = 0; i < 4; ++i)
#pragma unroll
        for (int j = 0; j < 2; ++j) *(LAS f32x4*)(part + (16 * i + m) * 32 + 16 * j + 4 * kq) = acc[i][j];
    LDS_WAIT(); __syncthreads();
    {
        const LAS float* pp = (const LAS float*)lds + rl * 32 + cl;
        f32x4 s1 = *(const LAS f32x4*)pp + *(const LAS f32x4*)(pp + 2048) + *(const LAS f32x4*)(pp + 4096) + *(const LAS f32x4*)(pp + 6144);
        f32x4 s2 = *(const LAS f32x4*)(pp + 8192) + *(const LAS f32x4*)(pp + 10240) + *(const LAS f32x4*)(pp + 12288) + *(const LAS f32x4*)(pp + 14336);
        if (MODE == 0) {
            u32x2 w; w.x = cvt_pk_bf16(s1[0] * bf_lo(gs.x) + s2[0] * bf_lo(gf.x), s1[1] * bf_hi(gs.x) + s2[1] * bf_hi(gf.x));
            w.y = cvt_pk_bf16(s1[2] * bf_lo(gs.y) + s2[2] * bf_lo(gf.y), s1[3] * bf_hi(gs.y) + s2[3] * bf_hi(gf.y));
            *(u32x2*)(mrg_s + (size_t)row * 2048 + col) = w;
        } else {
            *(f32x4*)(ys + (size_t)row * 2048 + col) = s1 + s2 + xin;
        }
    }
    LDS_WAIT(); __syncthreads();
}

#define XB_TMO      128
#define XB_XCNT(j)  (256  + 64 * (j))
#define XB_XSUB(j)  (1280 + 64 * (j))
#define XB_XGEN(j)  (2304 + 64 * (j))
#define XB_TOP      3328
#define XB_TOPGEN   3392
#define XCD_BAR_WORDS 3456
#define XB_SPIN_CAP (1u << 18)
__device__ __forceinline__ unsigned xb_ld(unsigned* p)              { return __hip_atomic_load(p, __ATOMIC_RELAXED, __HIP_MEMORY_SCOPE_AGENT); }
__device__ __forceinline__ unsigned xb_add(unsigned* p, unsigned v) { return __hip_atomic_fetch_add(p, v, __ATOMIC_RELAXED, __HIP_MEMORY_SCOPE_AGENT); }
__device__ __forceinline__ unsigned xb_xcc_id() { return (unsigned)__builtin_amdgcn_s_getreg((3 << 11) | 20) & 0xFu; }
#define XB_SPIN(cond, bar) do { unsigned _sp = 0; while (cond) { __builtin_amdgcn_s_sleep(1); \
    if ((++_sp & 255u) == 0u) { if (xb_ld(&(bar)[XB_TMO])) break; if (_sp > XB_SPIN_CAP) { atomicAdd(&(bar)[XB_TMO], 1u); break; } } } } while (0)
struct XcdBarrier { unsigned* bar; unsigned x; volatile LAS unsigned* st; int wave; };
__device__ __forceinline__ XcdBarrier xcd_barrier_post(unsigned* bar, volatile LAS unsigned* st, int wave) {
    XcdBarrier b; b.bar = bar; b.x = xb_xcc_id(); b.st = st; b.wave = wave;
    if (wave == 0 && lane_id() == 0) (void)xb_add(&bar[XB_XCNT(b.x)], 1u);
    return b;
}
__device__ __forceinline__ void xcd_barrier_complete(unsigned* bar, unsigned x, unsigned& nloc, unsigned& nx) {
    const unsigned G = gridDim.x * gridDim.y * gridDim.z;
    unsigned sum, cnt, mine, sp = 0u;
    for (;;) {
        sum = 0u; cnt = 0u; mine = 0u;
#pragma unroll
        for (unsigned j = 0; j < 16; ++j) { const unsigned c = xb_ld(&bar[XB_XCNT(j)]); sum += c; cnt += (c > 0u) ? 1u : 0u; mine = (j == x) ? c : mine; }
        if (sum == G) break;
        __builtin_amdgcn_s_sleep(1);
        if ((++sp & 255u) == 0u) { if (xb_ld(&bar[XB_TMO])) break; if (sp > XB_SPIN_CAP) { atomicAdd(&bar[XB_TMO], 1u); break; } }
    }
    nloc = mine > 0u ? mine : 1u; nx = cnt > 0u ? cnt : 1u;
}
__device__ __forceinline__ void xcd_barrier(const XcdBarrier& b) {
    asm volatile("s_waitcnt vmcnt(0)" ::: "memory");
    __syncthreads();
    if (b.wave == 0 && lane_id() == 0) {
        unsigned* bar = b.bar;
        __builtin_amdgcn_s_waitcnt(0);
        unsigned nloc = b.st[0], nx = b.st[1];
        if (nloc == 0u) { xcd_barrier_complete(bar, b.x, nloc, nx); b.st[0] = nloc; b.st[1] = nx; }
        const unsigned old = xb_add(&bar[XB_XSUB(b.x)], 1u);
        const unsigned gen = old / nloc;
        if (old + 1u == (gen + 1u) * nloc) {
            __builtin_amdgcn_fence(__ATOMIC_RELEASE, "agent");
            asm volatile("s_waitcnt vmcnt(0)" ::: "memory");
            const unsigned og = xb_add(&bar[XB_TOP], 1u);
            const unsigned tg = og / nx;
            if (og + 1u == (tg + 1u) * nx) xb_add(&bar[XB_TOPGEN], 1u);
            else XB_SPIN(xb_ld(&bar[XB_TOPGEN]) == tg, bar);
            __builtin_amdgcn_fence(__ATOMIC_ACQUIRE, "agent");
            xb_add(&bar[XB_XGEN(b.x)], 1u);
            asm volatile("s_waitcnt vmcnt(0)" ::: "memory");
        } else {
            XB_SPIN(xb_ld(&bar[XB_XGEN(b.x)]) == gen, bar);
            __builtin_amdgcn_fence(__ATOMIC_ACQUIRE, "agent");
            asm volatile("s_waitcnt vmcnt(0)" ::: "memory");
        }
    }
    __syncthreads();
}

__device__ __forceinline__ float wave_sum(float v) {
#pragma unroll
    for (int o = 1; o < 64; o <<= 1) v += __shfl_xor(v, o);
    return v;
}
__device__ __forceinline__ void p0_transpose_item(const float* W, int ld, int nblk, bf16* WT, int ldt, LAS float* scr, int item, int lane) {
    const int kb = item / nblk, nb = item % nblk, k0 = 64 * kb, n0 = 32 * nb;
#pragma unroll 8
    for (int i = 0; i < 32; ++i) { const int kk = 2 * i + (lane >> 5); scr[kk * 33 + (lane & 31)] = __builtin_nontemporal_load(W + (size_t)(k0 + kk) * ld + n0 + (lane & 31)); }
    LDS_WAIT(); asm volatile("" ::: "memory");
    const int c = lane & 7;
#pragma unroll
    for (int j = 0; j < 4; ++j) { const int n = (lane >> 3) + 8 * j; const LAS float* s = scr + (8 * c) * 33 + n;
        u32x4 o; o.x = cvt_pk_bf16(s[0 * 33], s[1 * 33]); o.y = cvt_pk_bf16(s[2 * 33], s[3 * 33]); o.z = cvt_pk_bf16(s[4 * 33], s[5 * 33]); o.w = cvt_pk_bf16(s[6 * 33], s[7 * 33]);
        *(u32x4*)(WT + (size_t)(n0 + n) * ldt + k0 + 8 * c) = o; }
    LDS_WAIT(); asm volatile("" ::: "memory");
}

struct Ptrs {
    const float *xp, *xs, *csbk, *csbv, *cfxk, *cfxv, *cflf, *normw, *win, *bfor, *qnw, *knw, *wbsb, *wbfx, *wout;
    float* out; unsigned char* ws;
};

__device__ __forceinline__ void p0_prologue(const Ptrs& P, LAS unsigned char* lds, int gw, int NGW, int wave, int lane, int tid) {
    LAS float* wfT = (LAS float*)(lds + 69632);
    for (int i = tid; i < 2048 * 2; i += 512) { const int k = i >> 1, hf = i & 1; const f32x4 v = *(const f32x4*)(P.win + (size_t)k * DIN + 8192 + 4 * hf);
#pragma unroll
        for (int j = 0; j < 4; ++j) wfT[(4 * hf + j) * 2048 + k] = v[j]; }
    LAS float* scr = (LAS float*)(lds + wave * 8448);
    constexpr int I_A = 32 * 256, I_B = 32 * 128, NITEMS = I_A + I_B;
    bf16* Wt = (bf16*)(P.ws + WS_WIN);
    for (int it = gw; it < NITEMS; it += NGW) {
        int r = it;
        if (r < I_A) { p0_transpose_item(P.win, DIN, 256, Wt, 2048, scr, r, lane); continue; } r -= I_A;
        p0_transpose_item(P.win + 8200, DIN, 128, Wt + (size_t)8192 * 2048, 2048, scr, r, lane);
    }
    __syncthreads();
    f32x4 nw[8];
#pragma unroll
    for (int i = 0; i < 8; ++i) nw[i] = *(const f32x4*)(P.normw + 4 * lane + 256 * i);
    bf16* H = (bf16*)(P.ws + WS_H);
    for (int m = gw; m < TT; m += NGW) {
        const float* xr = (m < TP) ? P.xp + (size_t)m * DM : P.xs + (size_t)(m - TP) * DM;
        f32x4 v[8]; float ss = 0.f;
#pragma unroll
        for (int i = 0; i < 8; ++i) { v[i] = __builtin_nontemporal_load((const f32x4*)(xr + 4 * lane + 256 * i)); ss += (v[i][0] * v[i][0] + v[i][1] * v[i][1]) + (v[i][2] * v[i][2] + v[i][3] * v[i][3]); }
        const float rstd = 1.0f / sqrtf(wave_sum(ss) * (1.0f / DM) + RMS_EPS);
        unsigned long long* o8 = (unsigned long long*)(H + (size_t)m * DM) + lane;
        float fl[8] = {0.f, 0.f, 0.f, 0.f, 0.f, 0.f, 0.f, 0.f};
#pragma unroll
        for (int i = 0; i < 8; ++i) { v[i] = v[i] * rstd * nw[i];
            o8[64 * i] = (unsigned long long)cvt_pk_bf16(v[i][0], v[i][1]) | ((unsigned long long)cvt_pk_bf16(v[i][2], v[i][3]) << 32);
#pragma unroll
            for (int j = 0; j < 8; ++j) { const f32x4 w = *(const LAS f32x4*)(wfT + j * 2048 + 4 * lane + 256 * i); fl[j] += (v[i][0] * w[0] + v[i][1] * w[1]) + (v[i][2] * w[2] + v[i][3] * w[3]); } }
        float mine = 0.f;
#pragma unroll
        for (int j = 0; j < 8; ++j) { const float t = wave_sum(fl[j]); mine = (lane == j) ? t : mine; }
        if (lane < 8) { const float z = mine + P.bfor[lane]; const float lf = fminf(z, 0.f) - log1pf(expf(-fabsf(z)));
            float* dst = (m < TP) ? P.out + O_PLF + (size_t)m * 8 : P.out + O_SLF + (size_t)(m - TP) * 8; dst[lane] = lf; }
    }
}

__device__ __forceinline__ void p1_side_weights(const Ptrs& P, LAS unsigned char* lds, int sw, int nsw, int wave, int lane) {
    LAS float* scr = (LAS float*)(lds + wave * 8448);
    constexpr int I_S = 16 * 64, I_O = 32 * 64, NITEMS = 2 * I_S + I_O;
    bf16* Wb = (bf16*)(P.ws + WS_WB); bf16* Wo = (bf16*)(P.ws + WS_WO);
    for (int it = sw; it < NITEMS; it += nsw) {
        int r = it;
        if (r < I_S) { p0_transpose_item(P.wbsb, 2048, 64, Wb, 2048, scr, r, lane); continue; } r -= I_S;
        if (r < I_S) { p0_transpose_item(P.wbfx, 2048, 64, Wb + 1024, 2048, scr, r, lane); continue; } r -= I_S;
        p0_transpose_item(P.wout, 2048, 64, Wo, 2048, scr, r, lane);
    }
}

__device__ __forceinline__ void p1_side_knorm(const Ptrs& P, int sw, int nsw, int lane) {
    const int r32 = lane & 31, hi = lane >> 5;
    float* kmx = (float*)(P.ws + WS_KMX);
    for (int it = sw; it < NBAT * NH * KN_TILES; it += nsw) {
        const int h = it & 7, bt = it >> 3, b = bt / KN_TILES, tix = bt - b * KN_TILES, bh = b * 8 + h;
        const float* src = P.cfxk + ((size_t)(b * PAST + tix * 32 + hi) * NH + h) * HD + r32 * 4;
        float mx = 0.f;
#pragma unroll 1
        for (int half = 0; half < 2; ++half) {
            f32x4 t[8];
#pragma unroll
            for (int i = 0; i < 8; ++i) t[i] = __builtin_nontemporal_load((const f32x4*)(src + (size_t)(half * 8 + i) * 2 * NH * HD));
#pragma unroll
            for (int i = 0; i < 8; ++i) { float s_ = t[i][0] * t[i][0] + t[i][1] * t[i][1] + t[i][2] * t[i][2] + t[i][3] * t[i][3];
#pragma unroll
                for (int o = 1; o < 32; o <<= 1) s_ += __shfl_xor(s_, o);
                mx = fmaxf(mx, s_); }
        }
        mx = fmaxf(mx, __shfl_xor(mx, 32));
        if (lane == 0) kmx[bh * 128 + tix] = mx;
    }
}

__device__ __forceinline__ void scan_seq(const Ptrs& P, LAS unsigned char* lds, int id, int tid) {
    LAS float* sm = (LAS float*)(lds + XCH_OFF);
    const float* s1; int n1, st1; const float* s2; int n2; float* dst;
    if (id < 8) { s1 = P.out + O_PLF + id; n1 = TP; st1 = 8; s2 = s1; n2 = 0; dst = (float*)(P.ws + WS_F2P) + (size_t)id * TP; }
    else { const int b = (id - 8) >> 3, j = (id - 8) & 7; s1 = P.cflf + (size_t)b * PAST * 8 + j; n1 = PAST; st1 = 8; s2 = P.out + O_SLF + (size_t)b * NSEQ * 8 + j; n2 = NSEQ;
        dst = (float*)(P.ws + WS_F2S) + (size_t)(b * 8 + j) * KT; }
    const int n = n1 + n2, CH = (n + 511) / 512;
    float v[16]; float run = 0.f;
#pragma unroll
    for (int i = 0; i < 16; ++i) { const int idx = tid * CH + i; if (i < CH && idx < n) { const float x = idx < n1 ? s1[(size_t)idx * st1] : s2[(size_t)(idx - n1) * 8]; run += x; } v[i] = run; }
    const int lane = tid & 63, wave = tid >> 6;
    float inc = run;
#pragma unroll
    for (int o = 1; o < 64; o <<= 1) { const float t = __shfl_up(inc, o); if (lane >= o) inc += t; }
    if (lane == 63) sm[wave] = inc;
    LDS_WAIT(); __syncthreads();
    float base = inc - run;
    for (int w = 0; w < wave; ++w) base += sm[w];
#pragma unroll
    for (int i = 0; i < 16; ++i) { const int idx = tid * CH + i; if (i < CH && idx < n) dst[idx] = (base + v[i]) * LOG2E; }
    __syncthreads();
}

namespace att {
constexpr int SHM_T = 16384;
#define KSWZ(row, colB) ((row) * 256 + ((colB) ^ (((row) & 7) << 4)))
__device__ __forceinline__ int v_st(int k, int c) { const int kk = (k & ~0xC) | ((k & 4) << 1) | ((k & 8) >> 1); return ((kk >> 3) * 4 + (c >> 5)) * 512 + ((kk & 7) * 32 + (c & 31)) * 2; }
__device__ __forceinline__ int v_rd_base(int lane) { return ((lane & 3) << 3) | (((lane >> 2) & 3) << 6) | (((lane >> 4) & 1) << 5) | (((lane >> 5) & 1) << 8); }
__device__ __forceinline__ int crow(int r, int hi) { return (r & 3) + 8 * (r >> 2) + 4 * hi; }

__device__ __forceinline__ __amdgpu_buffer_rsrc_t mk_rsrc(const void* p, int bytes) {
    const unsigned long long a = (unsigned long long)p;
    const unsigned lo = __builtin_amdgcn_readfirstlane((unsigned)a), hi = __builtin_amdgcn_readfirstlane((unsigned)(a >> 32));
    return __builtin_amdgcn_make_buffer_rsrc((void*)(((unsigned long long)hi << 32) | lo), 0, bytes, 0x00020000);
}
template <int NB>
__device__ __forceinline__ void qkt(f32x16& p0, f32x16& p1, const LAS char* Kb, int r32, int hi, const bf16x8 (&qr)[8]) {
    p0 = (f32x16){0.f, 0.f, 0.f, 0.f, 0.f, 0.f, 0.f, 0.f, 0.f, 0.f, 0.f, 0.f, 0.f, 0.f, 0.f, 0.f}; p1 = p0;
    const LAS char* kb[4];
#pragma unroll
    for (int dd = 0; dd < 4; ++dd) kb[dd] = Kb + KSWZ(r32, (dd * 16 + hi * 8) * 2);
#pragma unroll
    for (int d0 = 0; d0 < 8; ++d0) { const LAS char* a = kb[d0 & 3] + (d0 >> 2) * 128;
        const bf16x8 b0 = *(const LAS bf16x8*)a;
        p0 = __builtin_amdgcn_mfma_f32_32x32x16_bf16(b0, qr[d0], p0, 0, 0, 0);
        if (NB == 2) { const bf16x8 b1 = *(const LAS bf16x8*)(a + 32 * 256); p1 = __builtin_amdgcn_mfma_f32_32x32x16_bf16(b1, qr[d0], p1, 0, 0, 0); } }
}
__device__ __forceinline__ void qkt_qlds(f32x16& p0, const LAS char* Kb, const LAS char* Qb, int r32, int hi, int qrow) {
    p0 = (f32x16){0.f, 0.f, 0.f, 0.f, 0.f, 0.f, 0.f, 0.f, 0.f, 0.f, 0.f, 0.f, 0.f, 0.f, 0.f, 0.f};
    const LAS char* kb[4];
#pragma unroll
    for (int dd = 0; dd < 4; ++dd) kb[dd] = Kb + KSWZ(r32, (dd * 16 + hi * 8) * 2);
    const LAS char* qb = Qb + qrow * 256;
#pragma unroll
    for (int d0 = 0; d0 < 8; ++d0) { const LAS char* a = kb[d0 & 3] + (d0 >> 2) * 128;
        const bf16x8 b0 = *(const LAS bf16x8*)a;
        const bf16x8 q = *(const LAS bf16x8*)(qb + (((d0 * 2 + hi) ^ qrow) << 4));
        p0 = __builtin_amdgcn_mfma_f32_32x32x16_bf16(b0, q, p0, 0, 0, 0); }
}
template <int NB>
__device__ __forceinline__ void pv_tile(f32x16 (&o)[4], int vb0, bf16x8 pa0, bf16x8 pa1, bf16x8 pa2, bf16x8 pa3) {
#define TRRD(dst, off) asm volatile("ds_read_b64_tr_b16 %0, %1 offset:%2" : "=&v"(dst) : "v"(vb0), "i"(off) : "memory")
#define PV_D0(d0) do { s16x4 l0, l1, l2, l3, h0, h1, h2, h3; constexpr int b_ = (d0) * 512;   \
        TRRD(l0, b_); TRRD(h0, b_ + 2048); TRRD(l1, b_ + 4096); TRRD(h1, b_ + 6144);   \
        if (NB == 2) { TRRD(l2, b_ + 8192); TRRD(h2, b_ + 10240); TRRD(l3, b_ + 12288); TRRD(h3, b_ + 14336); }   \
        asm volatile("s_waitcnt lgkmcnt(0)" ::: "memory"); __builtin_amdgcn_sched_barrier(0);   \
        o[d0] = __builtin_amdgcn_mfma_f32_32x32x16_bf16(pa0, (bf16x8){l0[0], l0[1], l0[2], l0[3], h0[0], h0[1], h0[2], h0[3]}, o[d0], 0, 0, 0);   \
        o[d0] = __builtin_amdgcn_mfma_f32_32x32x16_bf16(pa1, (bf16x8){l1[0], l1[1], l1[2], l1[3], h1[0], h1[1], h1[2], h1[3]}, o[d0], 0, 0, 0);   \
        if (NB == 2) {   \
        o[d0] = __builtin_amdgcn_mfma_f32_32x32x16_bf16(pa2, (bf16x8){l2[0], l2[1], l2[2], l2[3], h2[0], h2[1], h2[2], h2[3]}, o[d0], 0, 0, 0);   \
        o[d0] = __builtin_amdgcn_mfma_f32_32x32x16_bf16(pa3, (bf16x8){l3[0], l3[1], l3[2], l3[3], h3[0], h3[1], h3[2], h3[3]}, o[d0], 0, 0, 0); } } while (0)
    PV_D0(0); PV_D0(1); PV_D0(2); PV_D0(3);
#undef PV_D0
#undef TRRD
}
#define PK4(P, B_, OUT) do { unsigned a0 = cvt_pk_bf16(P[B_+0], P[B_+1]), a1 = cvt_pk_bf16(P[B_+2], P[B_+3]);   \
        unsigned b0 = cvt_pk_bf16(P[B_+4], P[B_+5]), b1 = cvt_pk_bf16(P[B_+6], P[B_+7]);   \
        auto r0 = __builtin_amdgcn_permlane32_swap(a0, b0, false, false); auto r1 = __builtin_amdgcn_permlane32_swap(a1, b1, false, false);   \
        u32x4 w = {r0[0], r1[0], r0[1], r1[1]}; OUT = __builtin_bit_cast(bf16x8, w); } while (0)

__device__ __forceinline__ void xchg32(float v, float& x0, float& x1) {
    const unsigned a = __builtin_bit_cast(unsigned, v);
    auto rr = __builtin_amdgcn_permlane32_swap(a, a, false, false);
    const unsigned r0 = rr[0], r1 = rr[1];
    x0 = __builtin_bit_cast(float, r0); x1 = __builtin_bit_cast(float, r1);
}
template <int NB, bool MASK>
__device__ __forceinline__ float sb_step_a(f32x16& p0, f32x16& p1, int dq, int hi, float (&PS)[8], float (&GS)[8]) {
#pragma unroll
    for (int r = 0; r < 16; ++r) {
        const int c = (r & 3) + 8 * (r >> 2);
        float a = __builtin_amdgcn_rcpf(1.0f + __builtin_amdgcn_exp2f(p0[r])); if (MASK) a = (c < dq) ? a : 1.0f; p0[r] = a;
        if (NB == 2) { float b = __builtin_amdgcn_rcpf(1.0f + __builtin_amdgcn_exp2f(p1[r])); if (MASK) b = (c + 32 < dq) ? b : 1.0f; p1[r] = b; }
    }
    float tot = 1.0f;
#pragma unroll
    for (int g = 0; g < 4 * NB; ++g) {
        const int r = 4 * (g & 3);
        const float G = (g < 4) ? (p0[r] * p0[r + 1]) * (p0[r + 2] * p0[r + 3]) : (p1[r] * p1[r + 1]) * (p1[r + 2] * p1[r + 3]);
        float x0, x1; xchg32(G, x0, x1);
        PS[g] = x0 * x1; GS[g] = hi ? 1.0f : x1; tot *= PS[g];
    }
    return tot;
}
template <int NB>
__device__ __forceinline__ void sb_step_b(f32x16& p0, f32x16& p1, float C, const float (&PS)[8], const float (&GS)[8], bf16x8& pa0, bf16x8& pa1, bf16x8& pa2, bf16x8& pa3) {
    float X = C;
#pragma unroll
    for (int g = 4 * NB - 1; g >= 0; --g) {
        const int r = 4 * (g & 3);
        const float E = X * GS[g];
        if (g < 4) { const float a0 = p0[r], a1 = p0[r + 1], a2 = p0[r + 2], a3 = p0[r + 3]; const float P3 = E, P2 = P3 * a3, P1 = P2 * a2, P0 = P1 * a1;
            p0[r + 3] = __builtin_fmaf(-P3, a3, P3); p0[r + 2] = __builtin_fmaf(-P2, a2, P2); p0[r + 1] = __builtin_fmaf(-P1, a1, P1); p0[r] = __builtin_fmaf(-P0, a0, P0); }
        else { const float a0 = p1[r], a1 = p1[r + 1], a2 = p1[r + 2], a3 = p1[r + 3]; const float P3 = E, P2 = P3 * a3, P1 = P2 * a2, P0 = P1 * a1;
            p1[r + 3] = __builtin_fmaf(-P3, a3, P3); p1[r + 2] = __builtin_fmaf(-P2, a2, P2); p1[r + 1] = __builtin_fmaf(-P1, a1, P1); p1[r] = __builtin_fmaf(-P0, a0, P0); }
        X *= PS[g];
    }
    PK4(p0, 0, pa0); PK4(p0, 8, pa1);
    if (NB == 2) { PK4(p1, 0, pa2); PK4(p1, 8, pa3); }
}
template <int NB, bool MASK, class FPtr>
__device__ __forceinline__ float fox_weights(f32x16& p0, f32x16& p1, FPtr F2k, int dq, float& m, float& l, float& alpha, bf16x8& pa0, bf16x8& pa1, bf16x8& pa2, bf16x8& pa3) {
    const float NEG = -__builtin_inff();
    float mx = NEG;
#pragma unroll
    for (int g = 0; g < 4; ++g) {
        const f32x4 f0 = F2k[2 * g];
#pragma unroll
        for (int i = 0; i < 4; ++i) { float x = p0[4 * g + i] - f0[i]; if (MASK) x = (i + 8 * g <= dq) ? x : NEG; p0[4 * g + i] = x; mx = fmaxf(mx, x); }
        if (NB == 2) { const f32x4 f1 = F2k[8 + 2 * g];
#pragma unroll
            for (int i = 0; i < 4; ++i) { float x = p1[4 * g + i] - f1[i]; if (MASK) x = (i + 8 * g + 32 <= dq) ? x : NEG; p1[4 * g + i] = x; mx = fmaxf(mx, x); } }
    }
    { float x0, x1; xchg32(mx, x0, x1); mx = fmaxf(x0, x1); }
    const float mn = fmaxf(m, mx);
    alpha = __builtin_amdgcn_exp2f(m - mn); m = mn;
    float ps = 0.f;
#pragma unroll
    for (int r = 0; r < 16; ++r) { p0[r] = __builtin_amdgcn_exp2f(p0[r] - mn); ps += p0[r]; if (NB == 2) { p1[r] = __builtin_amdgcn_exp2f(p1[r] - mn); ps += p1[r]; } }
    { float x0, x1; xchg32(ps, x0, x1); ps = x0 + x1; }
    l = l * alpha + ps;
    PK4(p0, 0, pa0); PK4(p0, 8, pa1);
    if (NB == 2) { PK4(p1, 0, pa2); PK4(p1, 8, pa3); }
    return ps;
}

__device__ __forceinline__ void qk_half(f32x16& p, const LAS char* Kb, int r32, int hi, const LAS char* qx, int rx) {
    p = (f32x16){0.f, 0.f, 0.f, 0.f, 0.f, 0.f, 0.f, 0.f, 0.f, 0.f, 0.f, 0.f, 0.f, 0.f, 0.f, 0.f};
    const LAS char* kb[4];
#pragma unroll
    for (int dd = 0; dd < 4; ++dd) kb[dd] = Kb + KSWZ(r32, (dd * 16 + hi * 8) * 2);
#pragma unroll
    for (int d0 = 0; d0 < 8; ++d0) { const bf16x8 b0 = *(const LAS bf16x8*)(kb[d0 & 3] + (d0 >> 2) * 128);
        const bf16x8 q = *(const LAS bf16x8*)(qx + (((d0 * 2 + hi) ^ rx) << 4));
        p = __builtin_amdgcn_mfma_f32_32x32x16_bf16(b0, q, p, 0, 0, 0);
        if (d0 < 7) __builtin_amdgcn_sched_barrier(0x0011); }
}
template <bool UP>
__device__ __forceinline__ void pv_half(f32x16 (&o)[4], int vb0, bf16x8 pa0, bf16x8 pa1) {
#define TRRD(dst, off) asm volatile("ds_read_b64_tr_b16 %0, %1 offset:%2" : "=&v"(dst) : "v"(vb0), "i"(off) : "memory")
#define PV_D0(d0) do { s16x4 l0, l1, h0, h1; constexpr int b_ = (d0) * 512 + (UP ? 8192 : 0);   \
        TRRD(l0, b_); TRRD(h0, b_ + 2048); TRRD(l1, b_ + 4096); TRRD(h1, b_ + 6144);   \
        asm volatile("s_waitcnt lgkmcnt(0)" ::: "memory"); __builtin_amdgcn_sched_barrier(0);   \
        o[d0] = __builtin_amdgcn_mfma_f32_32x32x16_bf16(pa0, (bf16x8){l0[0], l0[1], l0[2], l0[3], h0[0], h0[1], h0[2], h0[3]}, o[d0], 0, 0, 0);   \
        o[d0] = __builtin_amdgcn_mfma_f32_32x32x16_bf16(pa1, (bf16x8){l1[0], l1[1], l1[2], l1[3], h1[0], h1[1], h1[2], h1[3]}, o[d0], 0, 0, 0); } while (0)
    PV_D0(0); PV_D0(1); PV_D0(2); PV_D0(3);
#undef PV_D0
#undef TRRD
}

template <int MODE>
__device__ __forceinline__ void prompt_block(LAS char* lds, const bf16* Qh, const bf16* Kh, const bf16* Vh, const float* F2h, const bf16* Gh, bf16* Ah, int qb, float zb, int wave_) {
    int tid_ = wave_ * 64 + lane_id(); asm volatile("" : "+v"(tid_));
    const int tid = tid_, wid = __builtin_amdgcn_readfirstlane(tid >> 6), lane = tid & 63, r32 = lane & 31, hi = lane >> 5;
    const int P0 = qb * 256, qlo = P0 + wid * 32, trow = qlo + r32;
    LAS char* Vl = lds; LAS char* Kl = lds + 2 * SHM_T;
    LAS float* wsm = (LAS float*)(lds + 5 * SHM_T) + wid * 64; LAS int* flg = (LAS int*)(lds + 5 * SHM_T + 2048);
    LAS float* fbuf = (LAS float*)(lds + 5 * SHM_T + 4096);
    LAS char* Qw = lds + 5 * SHM_T + 8192 + wid * 8192;
#pragma unroll
    for (int i = 0; i < 8; ++i) { const int idx = lane + 64 * i, r = idx >> 4, c = idx & 15;
        *(LAS bf16x8*)(Qw + r * 256 + ((c ^ (r & 15)) << 4)) = *(const bf16x8*)(Qh + (size_t)(qlo + r) * 128 + c * 8); }
    const LAS char* qx = Qw + r32 * 256; const int rx = r32 & 15;
    const int NT = 4 * qb + 4;
    const int sr = tid >> 4, sc = (tid & 15) * 8;
    const int kws = KSWZ(sr, sc * 2), vst0 = v_st(sr, sc), vst1 = v_st(32 + sr, sc);
    const int vrb = (int)(unsigned)(size_t)Vl + v_rd_base(lane);
    bf16x8 sk0, sk1, sv0, sv1; float sf = 0.f;
#define PB_KB(it_) ((NT - 1 - (it_)) * 64)
#define PB_ACT(hk_) ((MODE == 0) ? ((hk_) <= qlo + 30) : ((hk_) <= qlo + 31))
#define PB_NM(hk_) ((MODE == 0) ? ((hk_) + 31 >= qlo) : ((hk_) + 31 > qlo))
    const __amdgpu_buffer_rsrc_t rK = mk_rsrc(Kh, TT * 256), rV = mk_rsrc(Vh, TT * 256);
    const int svo = sr * 256 + sc * 2;
#define PB_LOADK(it_) do { const int so_ = PB_KB(it_) * 256; sk0 = __builtin_bit_cast(bf16x8, __builtin_amdgcn_raw_buffer_load_b128(rK, svo, so_, 0)); sk1 = __builtin_bit_cast(bf16x8, __builtin_amdgcn_raw_buffer_load_b128(rK, svo, so_ + 8192, 0)); } while (0)
#define PB_LOADV(it_) do { const int so_ = PB_KB(it_) * 256; sv0 = __builtin_bit_cast(bf16x8, __builtin_amdgcn_raw_buffer_load_b128(rV, svo, so_, 0)); sv1 = __builtin_bit_cast(bf16x8, __builtin_amdgcn_raw_buffer_load_b128(rV, svo, so_ + 8192, 0)); \
        if (MODE == 1 && tid < 64) sf = F2h[PB_KB(it_) + tid]; } while (0)
#define PB_WRITEK(ko_) do { *(LAS bf16x8*)(Kl + (ko_) + kws) = sk0; *(LAS bf16x8*)(Kl + (ko_) + kws + 32 * 256) = sk1; } while (0)
#define PB_WRITEV(bf) do { *(LAS bf16x8*)(Vl + (bf) * SHM_T + vst0) = sv0; *(LAS bf16x8*)(Vl + (bf) * SHM_T + vst1) = sv1; \
        if (MODE == 1 && tid < 64) fbuf[(bf) * 64 + tid] = sf; } while (0)
    PB_LOADK(0); PB_LOADV(0); PB_WRITEK(0); PB_WRITEV(0);
    if (NT > 1) { PB_LOADK(1); PB_WRITEK(SHM_T); }
    LDS_WAIT(); __syncthreads();
    f32x16 o[4];
#pragma unroll
    for (int d = 0; d < 4; ++d) o[d] = (f32x16){0.f, 0.f, 0.f, 0.f, 0.f, 0.f, 0.f, 0.f, 0.f, 0.f, 0.f, 0.f, 0.f, 0.f, 0.f, 0.f};
    float C = 1.0f, m_run = -1e30f, l_run = 0.f;
    f32x16 pA, pB, pdum;
    if (PB_ACT(PB_KB(0) + 32)) qk_half(pA, Kl + 32 * 256, r32, hi, qx, rx);
#define PB_WEIGHTS(MASK_, PC, dq_, fk_) do {                                                                                      \
        if (MODE == 0) { float PS[8], GS[8]; const float tot = sb_step_a<1, MASK_>(PC, pdum, dq_, hi, PS, GS);                      \
            sb_step_b<1>(PC, pdum, C, PS, GS, pa0, pa1, pa2, pa3); C *= tot; }                                                      \
        else { float alpha;                                                                                                        \
            fox_weights<1, MASK_>(PC, pdum, fk_, dq_, m_run, l_run, alpha, pa0, pa1, pa2, pa3);                                     \
            if (__any(alpha < 1.0f)) { if (hi == 0) wsm[r32] = alpha;                                                               \
                _Pragma("unroll") for (int r = 0; r < 16; ++r) { const float al = wsm[crow(r, hi)];                                 \
                    _Pragma("unroll") for (int d = 0; d < 4; ++d) o[d][r] *= al; } } } } while (0)
#define PB_HALF(UP_, PC, PN, hk_, kn_, hkn_) do {                                                                                 \
        const bool actC = PB_ACT(hk_), actN = PB_ACT(hkn_);                                                                        \
        if (actC) { bf16x8 pa0, pa1, pa2, pa3; const int dq = trow - (hk_) - 4 * hi;                                               \
            const LAS f32x4* fk = (const LAS f32x4*)(fbuf + buf * 64 + (UP_ ? 32 : 0) + 4 * hi);                                   \
            if (PB_NM(hk_)) { qk_half(PN, kn_, r32, hi, qx, rx); PB_WEIGHTS(true, PC, dq, fk); }                                        \
            else            { qk_half(PN, kn_, r32, hi, qx, rx); PB_WEIGHTS(false, PC, dq, fk); }                                       \
            pv_half<UP_>(o, vrb + buf * SHM_T, pa0, pa1);                                                                           \
        } else if (actN) qk_half(PN, kn_, r32, hi, qx, rx); } while (0)
    int ko = 0;
    for (int it = 0; it < NT; ++it) {
        const int buf = it & 1, kb = PB_KB(it);
        const int ko1 = (ko == 2 * SHM_T) ? 0 : ko + SHM_T, ko2 = (ko1 == 2 * SHM_T) ? 0 : ko1 + SHM_T;
        if (it + 2 < NT) PB_LOADK(it + 2);
        if (it + 1 < NT) PB_LOADV(it + 1);
        bool skip;
        if (MODE == 0) skip = __all(C < NEG_EPS) != 0; else skip = __all(m_run + fbuf[buf * 64 + 63] > zb) != 0;
        if (!skip) {
        PB_HALF(true, pA, pB, kb + 32, Kl + ko, kb);
        PB_HALF(false, pB, pA, kb, Kl + ko1 + 32 * 256, kb - 32);
        }
        if (it + 2 < NT) PB_WRITEK(ko2);
        if (it + 1 < NT) PB_WRITEV(buf ^ 1);
        if (lane == 0) flg[buf * 8 + wid] = skip ? 1 : 0;
        LDS_WAIT(); __syncthreads();
        { const LAS int* f = flg + buf * 8; if ((f[0] & f[1]) & (f[2] & f[3]) & (f[4] & f[5]) & (f[6] & f[7])) break; }
        ko = ko1;
    }
#undef PB_HALF
#undef PB_WEIGHTS
#undef PB_KB
#undef PB_ACT
#undef PB_NM
#undef PB_LOADK
#undef PB_LOADV
#undef PB_WRITEK
#undef PB_WRITEV
    float rli[16];
    if (MODE == 1) { if (hi == 0) wsm[32 + r32] = l_run;
#pragma unroll
        for (int r = 0; r < 16; ++r) rli[r] = __builtin_amdgcn_rcpf(wsm[32 + crow(r, hi)]); }
#pragma unroll
    for (int hf = 0; hf < 2; ++hf) {
        unsigned gq[8][4];
        const unsigned gb = ((unsigned)(qlo + 4 * hi + 16 * hf) * 128u + (unsigned)r32) * 2u;
#pragma unroll
        for (int r = 0; r < 8; ++r)
#pragma unroll
            for (int d = 0; d < 4; ++d)
                asm volatile("global_load_ushort %0, %1, %2 offset:%3" : "=&v"(gq[r][d]) : "v"(gb), "s"(Gh), "n"(((r & 3) + 8 * (r >> 2)) * 256 + 64 * d) : "memory");
        __builtin_amdgcn_sched_barrier(0);
        asm volatile("s_waitcnt vmcnt(0)" ::: "memory");
        __builtin_amdgcn_sched_barrier(0);
#pragma unroll
        for (int r8 = 0; r8 < 8; ++r8) { const int r = 8 * hf + r8; const unsigned row = (unsigned)(qlo + crow(r, hi));
            const unsigned aoff = (row * 2048u + (unsigned)r32) * 2u;
#pragma unroll
            for (int d = 0; d < 4; ++d) {
                float v = o[d][r]; if (MODE == 1) v *= rli[r];
                v *= __builtin_bit_cast(float, gq[r8][d] << 16);
                const float vn = __shfl_xor(v, 1);
                const unsigned w = cvt_pk_bf16(v, vn);
                if ((r32 & 1) == 0) {
                    if (d == 0) asm volatile("global_store_dword %0, %1, %2" :: "v"(aoff), "v"(w), "s"(Ah) : "memory");
                    else if (d == 1) asm volatile("global_store_dword %0, %1, %2 offset:64" :: "v"(aoff), "v"(w), "s"(Ah) : "memory");
                    else if (d == 2) asm volatile("global_store_dword %0, %1, %2 offset:128" :: "v"(aoff), "v"(w), "s"(Ah) : "memory");
                    else asm volatile("global_store_dword %0, %1, %2 offset:192" :: "v"(aoff), "v"(w), "s"(Ah) : "memory"); } } }
    }
    LDS_WAIT(); __syncthreads();
}

template <int MODE>
__device__ __forceinline__ void sample_unit(LAS char* lds, const bf16* Qs, const float* Kc, const float* Vc, const bf16* Kn, const bf16* Vn, const float* F2, const bf16* Gs, bf16* As, const float* Kmx, int wave_) {
    int tid_ = wave_ * 64 + lane_id(); asm volatile("" : "+v"(tid_));
    const int tid = tid_, wid = __builtin_amdgcn_readfirstlane(tid >> 6), lane = tid & 63, r32 = lane & 31, hi = lane >> 5, qrow = r32 & 15;
    LAS char* Kt = lds + wid * 16384; LAS char* Vt = Kt + 8192;
    LAS float* xch = (LAS float*)(lds + XCH_OFF);
    const int vrb = (int)(unsigned)(size_t)Vt + v_rd_base(lane);
    LAS char* Qb = lds + XCH_OFF + 4096;
    if (tid < 256) { const int r = tid >> 4, c = tid & 15; *(LAS bf16x8*)(Qb + r * 256 + ((c ^ r) << 4)) = *(const bf16x8*)(Qs + (size_t)r * 128 + c * 8); }
    LDS_WAIT(); __syncthreads();
    LAS float* qnt = (LAS float*)(lds + XCH_OFF + 8192 + 1024) + wid * 64;
    LAS float* ktb = (LAS float*)(lds + XCH_OFF + 8192) + wid * 32;
    if (MODE == 1) {
        float qn = 0.f;
#pragma unroll
        for (int c = 0; c < 16; ++c) { const bf16x8 qv = *(LAS bf16x8*)(Qb + qrow * 256 + ((c ^ qrow) << 4));
#pragma unroll
            for (int e = 0; e < 8; ++e) { const float f = bf2f(qv[e]); qn += f * f; } }
        qnt[lane] = sqrtf(qn);
        const int tix = 128 - 8 * ((lane & 15) + 1) + 7 - wid;
        float kn = (tix < KN_TILES) ? Kmx[tix] : 0.f;
        kn = fmaxf(kn, __builtin_bit_cast(float, __builtin_amdgcn_update_dpp(0, __builtin_bit_cast(int, kn), 0x128, 0xf, 0xf, false)));
        kn = fmaxf(kn, __builtin_bit_cast(float, __builtin_amdgcn_update_dpp(0, __builtin_bit_cast(int, kn), 0x124, 0xf, 0xf, false)));
        kn = fmaxf(kn, __builtin_bit_cast(float, __builtin_amdgcn_update_dpp(0, __builtin_bit_cast(int, kn), 0x122, 0xf, 0xf, false)));
        kn = fmaxf(kn, __builtin_bit_cast(float, __builtin_amdgcn_update_dpp(0, __builtin_bit_cast(int, kn), 0x121, 0xf, 0xf, false)));
        if (lane < 16) { ktb[lane] = (tix < KN_TILES) ? sqrtf(kn) * 1.01f : 3.0e38f; ktb[16 + lane] = F2[tix * 32 + 31]; }
    }
    f32x16 o[4];
#pragma unroll
    for (int d = 0; d < 4; ++d) o[d] = (f32x16){0.f, 0.f, 0.f, 0.f, 0.f, 0.f, 0.f, 0.f, 0.f, 0.f, 0.f, 0.f, 0.f, 0.f, 0.f, 0.f};
    const __amdgpu_buffer_rsrc_t rk = mk_rsrc(Kc, PAST * 4096), rv = mk_rsrc(Vc, PAST * 4096);
    const int voff = hi * 4096 + r32 * 16;
    int kwa[4]; const int vw0 = v_st(hi, r32 * 4);
#pragma unroll
    for (int q = 0; q < 4; ++q) kwa[q] = KSWZ(2 * q + hi, r32 * 8);
    float R = 1.0f, m_run = -1e30f, l_run = 0.f;
    f32x4 tk[16];
#define SU_SO(rho_) ((PAST - 256 * (rho_) + 32 * (7 - wid)) * 4096)
#define SU_LOADK(rho_) do { const int so_ = SU_SO(rho_); _Pragma("unroll") for (int i = 0; i < 16; ++i) tk[i] = __builtin_bit_cast(f32x4, __builtin_amdgcn_raw_buffer_load_b128(rk, voff, so_ + i * 8192, 2)); } while (0)
#define SU_LOADV(rho_) do { const int so_ = SU_SO(rho_); _Pragma("unroll") for (int i = 0; i < 16; ++i) tk[i] = __builtin_bit_cast(f32x4, __builtin_amdgcn_raw_buffer_load_b128(rv, voff, so_ + i * 8192, 2)); } while (0)
    f32x4 fr[8];
    if (MODE == 1) {
#pragma unroll
        for (int g = 0; g < 4; ++g) fr[2 * g] = *(const f32x4*)(F2 + (PAST - 256 + 32 * (7 - wid)) + 4 * hi + 8 * g); }
    SU_LOADK(1);
    __builtin_amdgcn_sched_barrier(0);
    bool prev_v = true;
    for (int rho = 0; rho <= PAST / 256; ++rho) {
        const bool valid = (rho > 0) || (wid == 0);
        const int s0 = (rho == 0) ? PAST : PAST - 256 * rho + 32 * (7 - wid);
        f32x16 p0, p1; bf16x8 pa0, pa1, pa2, pa3; float PS[8], GS[8]; float tot = 1.0f; bool need_v = valid, pre_v = false;
        if (valid) {
            if (rho == 0) {
#pragma unroll
                for (int i = 0; i < 4; ++i) { const int idx = lane + 64 * i, row = idx >> 4, ch = idx & 15;
                    const bf16x8 kv = *(const bf16x8*)(Kn + (size_t)row * 128 + ch * 8);
                    const bf16x8 z = (bf16x8){0, 0, 0, 0, 0, 0, 0, 0};
                    *(LAS bf16x8*)(Kt + KSWZ(row, ch * 16)) = kv; *(LAS bf16x8*)(Kt + KSWZ(row + 16, ch * 16)) = z; }
            } else {
#pragma unroll
                for (int i = 0; i < 16; ++i) { u32x2 w; w.x = cvt_pk_bf16(tk[i][0], tk[i][1]); w.y = cvt_pk_bf16(tk[i][2], tk[i][3]); *(LAS u32x2*)(Kt + kwa[i & 3] + (i >> 2) * 2048) = w; }
                __builtin_amdgcn_sched_barrier(0);
                pre_v = (MODE == 0) || prev_v;
                if (pre_v) SU_LOADV(rho);
                __builtin_amdgcn_sched_barrier(0);
            }
            qkt_qlds(p0, Kt, Qb, r32, hi, qrow);
            const int dq = qrow - 4 * hi;
            if (MODE == 0) { if (rho == 0) tot = sb_step_a<1, true>(p0, p1, dq, hi, PS, GS); else tot = sb_step_a<1, false>(p0, p1, dq, hi, PS, GS); }
            else { float alpha, ps;
                if (rho == 0) ps = fox_weights<1, true>(p0, p1, (const f32x4*)(F2 + s0 + 4 * hi), dq, m_run, l_run, alpha, pa0, pa1, pa2, pa3);
                else { ps = fox_weights<1, false>(p0, p1, (const f32x4*)fr, dq, m_run, l_run, alpha, pa0, pa1, pa2, pa3);
                    if (rho < PAST / 256) {
#pragma unroll
                        for (int g = 0; g < 4; ++g) fr[2 * g] = *(const f32x4*)(F2 + s0 - 256 + 4 * hi + 8 * g); } }
                need_v = __any(ps != 0.0f) != 0;
                if (__any(alpha < 1.0f)) { LAS float* al = xch + 768 + wid * 32; if (hi == 0) al[r32] = alpha;
#pragma unroll
                    for (int r = 0; r < 16; ++r) { const float a_ = al[crow(r, hi)];
#pragma unroll
                        for (int d = 0; d < 4; ++d) o[d][r] *= a_; } }
            }
        }
        if (MODE == 0) {
            LAS float* xr = xch + (rho & 1) * 256;
            if (hi == 0) xr[wid * 32 + r32] = tot;
            LDS_WAIT(); __builtin_amdgcn_s_barrier(); asm volatile("" ::: "memory");
            float Cin = R;
#pragma unroll
            for (int w = 0; w < 8; ++w) { const float tw = xr[w * 32 + r32]; if (w < wid) Cin *= tw; R *= tw; }
            if (valid) sb_step_b<1>(p0, p1, Cin, PS, GS, pa0, pa1, pa2, pa3);
        }
        const bool more = (rho < PAST / 256) && !(MODE == 0 && rho > 0 && __all(R < NEG_EPS)) && !(MODE == 1 && rho > 0 && __all(qnt[lane] * ktb[rho & 15] - ktb[16 + (rho & 15)] - m_run < -NEG_BITS));
        if (need_v) {
            if (rho == 0) {
#pragma unroll
                for (int i = 0; i < 4; ++i) { const int idx = lane + 64 * i, row = idx >> 4, ch = idx & 15;
                    const bf16x8 vv = *(const bf16x8*)(Vn + (size_t)row * 128 + ch * 8);
                    const bf16x8 z = (bf16x8){0, 0, 0, 0, 0, 0, 0, 0};
                    *(LAS bf16x8*)(Vt + v_st(row, ch * 8)) = vv; *(LAS bf16x8*)(Vt + v_st(row + 16, ch * 8)) = z; }
            } else {
                if (!pre_v) SU_LOADV(rho);
#pragma unroll
                for (int i = 0; i < 16; ++i) { u32x2 w; w.x = cvt_pk_bf16(tk[i][0], tk[i][1]); w.y = cvt_pk_bf16(tk[i][2], tk[i][3]); *(LAS u32x2*)(Vt + vw0 + ((i >> 1) & 1) * 2048 + (i & 1) * 128 + (i >> 3) * 4096 + ((i >> 2) & 1) * 256) = w; }
            }
            __builtin_amdgcn_sched_barrier(0);
            if (rho > 0 && more) SU_LOADK(rho + 1);
            __builtin_amdgcn_sched_barrier(0);
            pv_tile<1>(o, vrb, pa0, pa1, pa2, pa3);
        } else if (rho > 0 && more) SU_LOADK(rho + 1);
        if (rho > 0) prev_v = need_v;
        if (!more) break;
    }
#undef SU_SO
#undef SU_LOADK
#undef SU_LOADV
    LDS_WAIT(); __syncthreads();
    int tid2 = wave_ * 64 + lane_id(); asm volatile("" : "+v"(tid2));
    { const int l2 = tid2 & 63, c2 = l2 & 31, h2 = l2 >> 5;
    if (MODE == 1 && h2 == 0 && c2 < 16) { xch[512 + wid * 16 + c2] = m_run; xch[640 + wid * 16 + c2] = l_run; }
    LAS float* Op = (LAS float*)(lds + wid * 16384) + 4 * h2 * 128 + c2;
#pragma unroll
    for (int d = 0; d < 4; ++d)
#pragma unroll
        for (int r = 0; r < 8; ++r) Op[((r & 3) + 8 * (r >> 2)) * 128 + d * 32] = o[d][r]; }
    LDS_WAIT(); __syncthreads();
    {
        const int row = tid2 >> 5, col = (tid2 & 31) * 4;
        f32x4 num = (f32x4){0.f, 0.f, 0.f, 0.f}; float den = 0.f, M = -1e30f;
        const LAS float* xm = xch + 512 + row;
        if (MODE == 1) {
#pragma unroll 1
            for (int w = 0; w < 8; ++w) M = fmaxf(M, xm[w * 16]); }
        const LAS char* opb = lds + (row * 128 + col) * 4;
#pragma unroll 1
        for (int w = 0; w < 8; ++w) { const f32x4 v = *(const LAS f32x4*)(opb + w * 16384);
            if (MODE == 1) { const float f = __builtin_amdgcn_exp2f(xm[w * 16] - M); num += v * f; den += f * xm[128 + w * 16]; } else num += v; }
        if (MODE == 1) num = num * (1.0f / den);
        const u32x2 gw = *(const u32x2*)(Gs + (size_t)row * 128 + col);
        u32x2 ow; ow.x = cvt_pk_bf16(num[0] * bf_lo(gw.x), num[1] * bf_hi(gw.x)); ow.y = cvt_pk_bf16(num[2] * bf_lo(gw.y), num[3] * bf_hi(gw.y));
        *(u32x2*)(As + (size_t)row * 2048 + col) = ow;
    }
    LDS_WAIT(); __syncthreads();
}
}

struct Args { const float* in[15]; float* out; unsigned char* ws; int ph_lo, ph_hi, li, pad; };

__global__ void __launch_bounds__(512, 2) fwd(Args args) {
    extern __shared__ __attribute__((aligned(16))) unsigned char lds_raw[];
    LAS unsigned char* lds = (LAS unsigned char*)lds_raw;
    const int wave = __builtin_amdgcn_readfirstlane((int)threadIdx.x >> 6);
#define lane (lane_id())
#define tid (wave * 64 + lane_id())
    const int G = gridDim.x;
    Ptrs P;
    P.xp = args.in[0]; P.xs = args.in[1]; P.csbk = args.in[2]; P.csbv = args.in[3]; P.cfxk = args.in[4]; P.cfxv = args.in[5]; P.cflf = args.in[6]; P.normw = args.in[7];
    P.win = args.in[8]; P.bfor = args.in[9]; P.qnw = args.in[10]; P.knw = args.in[11]; P.wbsb = args.in[12]; P.wbfx = args.in[13]; P.wout = args.in[14];
    P.out = args.out; P.ws = args.ws;
    volatile LAS unsigned* MISC = (volatile LAS unsigned*)(lds + MISC_OFF);
    if (tid < 64) MISC[tid] = 0u;
    __syncthreads();
    unsigned* ctl = (unsigned*)(P.ws + WS_CTL);
    XcdBarrier bar; bar.bar = ctl + args.li * 4096; bar.x = 0; bar.st = nullptr; bar.wave = wave;
    if (N_LAUNCHES != N_PHASES) bar = xcd_barrier_post(ctl + args.li * 4096, MISC + 8, wave);
    const int lo = args.ph_lo, hi_ = args.ph_hi;
#define IN(k) (lo <= (k) && (k) < hi_)
#define BOTH(k) (IN(k) && IN((k) + 1))
#define GRID_BAR() do { if (N_LAUNCHES != N_PHASES) xcd_barrier(bar); } while (0)

    if (IN(0)) { p0_prologue(P, lds, blockIdx.x * 8 + wave, G * 8, wave, lane, tid);
        if (PROBE_DOUBLE == 0) { __syncthreads(); p0_prologue(P, lds, blockIdx.x * 8 + wave, G * 8, wave, lane, tid); }
        if (BOTH(0)) GRID_BAR(); }

    if (IN(1)) {
        pg8::Gemm g{(const bf16*)(P.ws + WS_H), (const bf16*)(P.ws + WS_WIN), TT, NPROJ, DM};
        pg8::StaticOrder S; S.init(TT, NPROJ, G, (int)blockIdx.x, WGM_P1);
        pg8::EpiInProj E{P.ws, P.out, P.qnw, P.knw, (LAS float*)(lds + XCH_OFF)};
        pg8::gemm_phase<pg8::EpiInProj, pg8::StaticOrder, true, true>(lds, g, S, E, wave);
        if (PROBE_DOUBLE == 1) { GRID_BAR(); pg8::gemm_phase<pg8::EpiInProj, pg8::StaticOrder, true, true>(lds, g, S, E, wave); }
        { const int ex = ((TT / 256) * (NPROJ / 256)) % G, nside = (ex > 0 && ex < G) ? G - ex : G, sid = (ex > 0 && ex < G) ? (int)blockIdx.x - ex : (int)blockIdx.x;
          if (sid >= 0) { __syncthreads();
              for (int id = sid; id < 8 + NBAT * NH; id += nside) scan_seq(P, lds, id, tid);
              p1_side_weights(P, lds, sid * 8 + wave, nside * 8, wave, lane);
              p1_side_knorm(P, sid * 8 + wave, nside * 8, lane); } }
        if (BOTH(1)) GRID_BAR();
    }

    if (IN(2)) {
        const bf16* ACT = (const bf16*)(P.ws + WS_ACT); constexpr size_t AS = ACT_STRIDE / 2;
        bf16* ACAT = (bf16*)(P.ws + WS_ACAT);
        LAS int* slot = (LAS int*)(lds + MISC_OFF + 64);
        float zb;
        { float a = fmaxf(fabsf(P.qnw[lane]), fabsf(P.qnw[lane + 64])), b = fmaxf(fabsf(P.knw[lane]), fabsf(P.knw[lane + 64]));
#pragma unroll
          for (int o = 1; o < 64; o <<= 1) { a = fmaxf(a, __shfl_xor(a, o)); b = fmaxf(b, __shfl_xor(b, o)); }
          zb = __builtin_bit_cast(float, __builtin_amdgcn_readfirstlane(__builtin_bit_cast(unsigned, 128.0f * a * b * QSCALE * 1.02f + NEG_BITS))); }
#define DQ_NEXT(q, var) do { if (tid == 0) *slot = (int)__hip_atomic_fetch_add(ctl + CW_QUEUE + 64 * (q), 1u, __ATOMIC_RELAXED, __HIP_MEMORY_SCOPE_AGENT); LDS_WAIT(); __syncthreads(); var = *slot; __syncthreads(); } while (0)
        { constexpr int qo = 0;
        if ((((int)blockIdx.x >> 3) & 1) == 0) { const int u = ((int)blockIdx.x >> 4) * 8 + ((int)blockIdx.x & 7);
            const int b = u >> 3, h = u & 7;
            const size_t ro = ((size_t)h * TT + TP + 16 * b) * 128, co = ((size_t)b * PAST * NH + h) * HD;
            att::sample_unit<1>((LAS char*)lds, ACT + A_QFX * AS + ro, P.cfxk + co, P.cfxv + co, ACT + A_KFX * AS + ro, ACT + A_VFX * AS + ro,
                                (const float*)(P.ws + WS_F2S) + (size_t)(b * 8 + h) * KT, ACT + A_GFX * AS + ro, ACAT + (size_t)(TP + 16 * b) * 2048 + 1024 + 128 * h, (const float*)(P.ws + WS_KMX) + (size_t)(b * 8 + h) * 128, wave); }
#define DQ_HEADS(QB, cur, u, hsel) do { if (wave == 0) { int hs_ = (cur), uu_ = 32;                                                                              \
            for (;;) { unsigned v_ = 0u; if (lane == 0) v_ = __hip_atomic_fetch_add(ctl + CW_QUEUE + 64 * ((QB) + hs_), 1u, __ATOMIC_RELAXED, __HIP_MEMORY_SCOPE_AGENT);   \
                uu_ = __builtin_amdgcn_readfirstlane((int)v_); if (uu_ < 32) break;                                                                                 \
                unsigned c_ = 32u; if (lane < 8) c_ = __hip_atomic_load(ctl + CW_QUEUE + 64 * ((QB) + lane), __ATOMIC_RELAXED, __HIP_MEMORY_SCOPE_AGENT);               \
                const unsigned m_ = (unsigned)__ballot(c_ < 32u) & 0xffu; if (m_ == 0u) { hs_ = -1; break; }                                                       \
                const unsigned rot_ = ((m_ >> home) | (m_ << (8 - home))) & 0xffu; hs_ = (home + __builtin_ctz(rot_)) & 7; }                                       \
            if (lane == 0) { slot[0] = uu_; slot[1] = hs_; } }                                                                                                     \
        LDS_WAIT(); __syncthreads(); u = slot[0]; hsel = slot[1]; __syncthreads(); } while (0)
        const int home = (int)blockIdx.x & 7;
        { int cur = home;
          for (;;) { int u, h; DQ_HEADS(16, cur, u, h); if (h < 0) break; cur = h; const size_t ho = (size_t)h * TT * 128;
              att::prompt_block<1>((LAS char*)lds, ACT + A_QFX * AS + ho, ACT + A_KFX * AS + ho, ACT + A_VFX * AS + ho, (const float*)(P.ws + WS_F2P) + (size_t)h * TP, ACT + A_GFX * AS + ho, ACAT + 1024 + 128 * h, 31 - u, zb, wave); } }
        { int cur = home;
          for (;;) { int u, h; DQ_HEADS(24, cur, u, h); if (h < 0) break; cur = h; const size_t ho = (size_t)h * TT * 128;
              att::prompt_block<0>((LAS char*)lds, ACT + A_QSB * AS + ho, ACT + A_KSB * AS + ho, ACT + A_VSB * AS + ho, (const float*)(P.ws + WS_F2P), ACT + A_GSB * AS + ho, ACAT + 128 * h, 31 - u, zb, wave); } }
#undef DQ_HEADS
        for (;;) { int u; DQ_NEXT(qo + 3, u); if (u >= NBAT * NH) break;
            const int b = u >> 3, h = u & 7;
            const size_t ro = ((size_t)h * TT + TP + 16 * b) * 128, co = ((size_t)b * PAST * NH + h) * HD;
            att::sample_unit<0>((LAS char*)lds, ACT + A_QSB * AS + ro, P.csbk + co, P.csbv + co, ACT + A_KSB * AS + ro, ACT + A_VSB * AS + ro,
                                (const float*)(P.ws + WS_F2S), ACT + A_GSB * AS + ro, ACAT + (size_t)(TP + 16 * b) * 2048 + 128 * h, nullptr, wave); }
        }
#undef DQ_NEXT
        if (BOTH(2)) GRID_BAR();
    }
    if (IN(3)) {
        pg8::Gemm g{(const bf16*)(P.ws + WS_ACAT), (const bf16*)(P.ws + WS_WB), TP, DM, DM};
        pg8::StaticOrder S; S.init(TP, DM, G, (int)blockIdx.x, WGM_P3);
        for (int u = blockIdx.x; u < 256; u += G)
            mini_gemm<0>(lds, (const bf16*)(P.ws + WS_ACAT) + (size_t)TP * 2048, (const bf16*)(P.ws + WS_WB), u, wave, lane, tid, (const bf16*)(P.ws + WS_MSIG) + (size_t)TP * 4096, (bf16*)(P.ws + WS_MRG) + (size_t)TP * 2048, nullptr, nullptr);
        pg8::EpiMerge E{(const bf16*)(P.ws + WS_MSIG), (bf16*)(P.ws + WS_MRG)};
        pg8::gemm_phase<pg8::EpiMerge, pg8::StaticOrder, true, true>(lds, g, S, E, wave);
        if (PROBE_DOUBLE == 3) { GRID_BAR(); pg8::gemm_phase<pg8::EpiMerge, pg8::StaticOrder, true, true>(lds, g, S, E, wave); }
        if (BOTH(3)) GRID_BAR();
    }

    if (IN(4)) {
        pg8::Gemm g{(const bf16*)(P.ws + WS_MRG), (const bf16*)(P.ws + WS_WO), TP, DM, DM};
        pg8::StaticOrder S; S.init(TP, DM, G, (int)blockIdx.x, WGM_P4);
        for (int u = blockIdx.x; u < 256; u += G)
            mini_gemm<1>(lds, (const bf16*)(P.ws + WS_MRG) + (size_t)TP * 2048, (const bf16*)(P.ws + WS_WO), u, wave, lane, tid, nullptr, nullptr, P.xs, P.out + O_YS);
        pg8::EpiOut E{P.xp, P.xs, P.out};
        pg8::gemm_phase<pg8::EpiOut, pg8::StaticOrder, true, true>(lds, g, S, E, wave);
    }
#undef IN
#undef BOTH
#undef GRID_BAR
#undef lane
#undef tid
}

extern "C" void kernel_launch(void* const* d_in, const int* in_sizes, int n_in, void* d_out, int out_size, void* d_ws, size_t ws_size, hipStream_t stream) {
    static int grid = 0;
    if (grid == 0) {
        if (n_in != 15 || out_size != (int)O_END || ws_size < WS_END) { fprintf(stderr, "kernel_launch: unexpected shapes (n_in %d, out %d, ws %zu)\n", n_in, out_size, ws_size); grid = -1; return; }
        int dev = 0, cus = 0, per_cu = 0;
        if (hipGetDevice(&dev) != hipSuccess || hipDeviceGetAttribute(&cus, hipDeviceAttributeMultiprocessorCount, dev) != hipSuccess) { grid = -1; return; }
        if (hipFuncSetAttribute((const void*)fwd, hipFuncAttributeMaxDynamicSharedMemorySize, LDS_BYTES) != hipSuccess) { fprintf(stderr, "kernel_launch: hipFuncSetAttribute failed\n"); grid = -1; return; }
        if (hipOccupancyMaxActiveBlocksPerMultiprocessor(&per_cu, (const void*)fwd, 512, LDS_BYTES) != hipSuccess || per_cu < 1) fprintf(stderr, "kernel_launch: occupancy query reports %d\n", per_cu);
        (void)hipGetLastError();
        grid = cus;
    }
    if (grid < 0) return;
    if (hipMemsetAsync((char*)d_ws + WS_CTL, 0, CTL_ZERO_BYTES, stream) != hipSuccess) return;
    Args a{};
    for (int i = 0; i < 15; ++i) a.in[i] = (const float*)d_in[i];
    a.out = (float*)d_out; a.ws = (unsigned char*)d_ws;
    for (int li = 0; li < N_LAUNCHES; ++li) {
        if (N_LAUNCHES == N_PHASES) { a.ph_lo = li; a.ph_hi = li + 1; } else { a.ph_lo = 0; a.ph_hi = N_PHASES; }
        a.li = li; a.pad = 0;
        hipLaunchKernelGGL(fwd, dim3(grid), dim3(512), LDS_BYTES, stream, a);
        const hipError_t le = hipPeekAtLastError();
        if (le != hipSuccess) { fprintf(stderr, "kernel_launch: launch %d failed: %s\n", li, hipGetErrorName(le)); break; }
    }
}
```
